# Optimizing an MI355X kernel written in HIP

```python
import jax, jax.numpy as jnp
from jax import lax
import numpy as np

D_MODEL = 2048
BATCH = 2
SEQ = 8192
DEPTH = 2
DEC_BATCH = 32
DEC_SEQ = 64
PAST_LEN = 4096

CHUNK = 64
N_BRANCH = 4
BRANCH_WIDTH = D_MODEL // 4
N_HEADS = 4
HEAD_DV = BRANCH_WIDTH // N_HEADS
GLA_DK = HEAD_DV // 2
GLA_LOW_RANK = 16
GLA_GATE_NORM = 16.0
HG_DK = HEAD_DV
GDN_DK = HEAD_DV
GDN_CONV = 4
GDN_QKV = 3 * N_HEADS * GDN_DK
RET_DK = HEAD_DV
ROPE_BASE = 10000.0
D_FF = 128 * ((8 * D_MODEL // 3 + 127) // 128)
FFN_CONV = 3
EPS = 1e-6

IN_SIZES = (
    N_HEADS * GLA_DK, N_HEADS * GLA_DK, BRANCH_WIDTH, BRANCH_WIDTH, GLA_LOW_RANK,
    N_HEADS * HG_DK, N_HEADS * HG_DK, BRANCH_WIDTH, BRANCH_WIDTH,
    GDN_QKV, BRANCH_WIDTH, N_HEADS, N_HEADS,
    N_HEADS * RET_DK, N_HEADS * RET_DK, BRANCH_WIDTH, BRANCH_WIDTH,
    N_BRANCH * D_MODEL,
)
N_IN = sum(IN_SIZES)
IN_SPLITS = tuple(int(s) for s in np.cumsum(IN_SIZES)[:-1])

kernel_name = "hybrid_gated_linear_stream_encoder_step"


def rms_norm(x, g):
    xf = x.astype(jnp.float32)
    y = xf * lax.rsqrt(jnp.mean(xf * xf, axis=-1, keepdims=True) + EPS)
    return (y * g.astype(jnp.float32)).astype(x.dtype)


def head_layer_norm(x, g, b):
    xf = x.astype(jnp.float32)
    mu = jnp.mean(xf, axis=-1, keepdims=True)
    xc = xf - mu
    y = xc * lax.rsqrt(jnp.mean(xc * xc, axis=-1, keepdims=True) + EPS)
    return (y * g.astype(jnp.float32) + b.astype(jnp.float32)).astype(x.dtype)


def l2_normalize(x):
    xf = x.astype(jnp.float32)
    return (xf * lax.rsqrt(jnp.sum(xf * xf, axis=-1, keepdims=True) + EPS)).astype(x.dtype)


def split_heads(x, d):
    return x.reshape(x.shape[:-1] + (x.shape[-1] // d, d))


def merge_heads(x):
    return x.reshape(x.shape[:-2] + (-1,))


def to_chunks(x, L):
    B, T = x.shape[:2]
    x = x.astype(jnp.float32).reshape((B, T // L, L) + x.shape[2:])
    return jnp.swapaxes(jnp.swapaxes(x, 0, 1), 2, 3)


def from_chunks(o):
    o = jnp.swapaxes(jnp.swapaxes(o, 2, 3), 0, 1)
    return o.reshape((o.shape[0], -1) + o.shape[3:])


def rotary(x, pos0):
    T, K = x.shape[1], x.shape[-1]
    pos = (pos0 + jnp.arange(T)).astype(jnp.float32)
    inv = 1.0 / (ROPE_BASE ** (jnp.arange(0, K, 2, dtype=jnp.float32) / K))
    ang = pos[:, None] * inv[None, :]
    cos, sin = jnp.cos(ang)[None, :, None, :], jnp.sin(ang)[None, :, None, :]
    xf = x.astype(jnp.float32)
    x1, x2 = xf[..., : K // 2], xf[..., K // 2:]
    return jnp.concatenate([x1 * cos - x2 * sin, x1 * sin + x2 * cos], axis=-1).astype(x.dtype)


def causal_dwconv(x, hist, w):
    W, T = w.shape[0], x.shape[1]
    xe = jnp.concatenate([hist.astype(x.dtype), x], axis=1)
    y = sum(xe[:, j:j + T] * w[j] for j in range(W))
    return y, xe[:, -(W - 1):]


def chunk_gla(q, k, v, log_f, s0):
    T = q.shape[1]
    L = min(CHUNK, T)
    incl = jnp.tril(jnp.ones((L, L), dtype=bool))

    def step(s, blk):
        qb, kb, vb, gb = blk
        b = jnp.cumsum(gb, axis=2)
        dec = jnp.exp(jnp.where(incl[:, :, None], b[:, :, :, None, :] - b[:, :, None, :, :], -jnp.inf))
        att = jnp.einsum("bhtk,bhsk,bhtsk->bhts", qb, kb, dec)
        o = jnp.einsum("bhts,bhsv->bhtv", att, vb) + jnp.einsum("bhtk,bhkv->bhtv", qb * jnp.exp(b), s)
        b_end = b[:, :, -1:, :]
        s = jnp.exp(b_end[:, :, 0, :])[..., None] * s + jnp.einsum("bhsk,bhsv->bhkv", kb * jnp.exp(b_end - b), vb)
        return s, o

    s, o = lax.scan(step, s0.astype(jnp.float32),
                    (to_chunks(q, L), to_chunks(k, L), to_chunks(v, L), to_chunks(log_f, L)))
    return from_chunks(o).astype(v.dtype), s.astype(s0.dtype)


def chunk_retention(q, k, v, log_g, s0):
    T = q.shape[1]
    L = min(CHUNK, T)
    incl = jnp.tril(jnp.ones((L, L), dtype=bool))

    def step(s, blk):
        qb, kb, vb, gb = blk
        b = jnp.cumsum(gb, axis=-1)
        dec = jnp.exp(jnp.where(incl, b[..., :, None] - b[..., None, :], -jnp.inf))
        att = jnp.einsum("bhtk,bhsk->bhts", qb, kb) * dec
        o = jnp.einsum("bhts,bhsv->bhtv", att, vb) + jnp.exp(b)[..., None] * jnp.einsum("bhtk,bhkv->bhtv", qb, s)
        b_end = b[..., -1:]
        s = jnp.exp(b_end)[..., None] * s + jnp.einsum("bhsk,bhsv->bhkv", kb * jnp.exp(b_end - b)[..., None], vb)
        return s, o

    s, o = lax.scan(step, s0.astype(jnp.float32),
                    (to_chunks(q, L), to_chunks(k, L), to_chunks(v, L), to_chunks(log_g, L)))
    return from_chunks(o).astype(v.dtype), s.astype(s0.dtype)


def chunk_gated_delta(q, k, v, beta, log_a, s0):
    T = q.shape[1]
    L = min(CHUNK, T)
    incl = jnp.tril(jnp.ones((L, L), dtype=bool))
    strict = jnp.tril(jnp.ones((L, L), dtype=bool), k=-1)

    def step(s, blk):
        qb, kb, vb, bb, gb = blk
        b = jnp.cumsum(gb, axis=-1)
        dec = jnp.exp(jnp.where(incl, b[..., :, None] - b[..., None, :], -jnp.inf))
        m = jnp.where(strict, jnp.einsum("bhtk,bhsk->bhts", kb, kb) * dec, 0.0) * bb[..., None]
        eb = jnp.exp(b)[..., None]
        rhs = bb[..., None] * (vb - eb * jnp.einsum("bhtk,bhkv->bhtv", kb, s))
        u = lax.linalg.triangular_solve(m, rhs, left_side=True, lower=True, unit_diagonal=True)
        att = jnp.einsum("bhtk,bhsk->bhts", qb, kb) * dec
        o = jnp.einsum("bhts,bhsv->bhtv", att, u) + eb * jnp.einsum("bhtk,bhkv->bhtv", qb, s)
        b_end = b[..., -1:]
        s = jnp.exp(b_end)[..., None] * s + jnp.einsum("bhsk,bhsv->bhkv", kb * jnp.exp(b_end - b)[..., None], u)
        return s, o

    s, o = lax.scan(step, s0.astype(jnp.float32),
                    (to_chunks(q, L), to_chunks(k, L), to_chunks(v, L), to_chunks(beta, L), to_chunks(log_a, L)))
    return from_chunks(o).astype(v.dtype), s.astype(s0.dtype)


def trunk_layer(x, states, p, lb, pos0):
    s_gla, s_hg, s_gdn, s_ret, c_gdn, c_ffn = states
    B, T, _ = x.shape
    f32 = jnp.float32
    h = rms_norm(x, p["norm_mix_g"])
    (gla_q, gla_k, gla_v, gla_g, gla_lr, hg_q, hg_f, hg_i, hg_g,
     gdn_qkv, gdn_z, gdn_b, gdn_a, ret_q, ret_k, ret_v, ret_g, merge) = jnp.split(h @ p["w_in"], IN_SPLITS, axis=-1)

    log_gk = jax.nn.log_sigmoid((gla_lr @ p["gla_w_gk"] + p["gla_b_gk"]).astype(f32)) / GLA_GATE_NORM
    o, s_gla = chunk_gla(split_heads(gla_q, GLA_DK) * GLA_DK ** -0.5, split_heads(gla_k, GLA_DK),
                         split_heads(gla_v, HEAD_DV), split_heads(log_gk, GLA_DK), s_gla)
    o_gla = merge_heads(rms_norm(o, p["gla_norm_g"]) * jax.nn.silu(split_heads(gla_g, HEAD_DV)))

    f = lb + (1.0 - lb) * jax.nn.sigmoid(hg_f.astype(f32))
    o, s_hg = chunk_gla(split_heads(jax.nn.silu(hg_q), HG_DK), split_heads((1.0 - f).astype(x.dtype), HG_DK),
                        split_heads(hg_i, HEAD_DV), split_heads(jnp.log(f), HG_DK), s_hg)
    o_hg = merge_heads(rms_norm(o, p["hgrn_norm_g"]) * jax.nn.silu(split_heads(hg_g, HEAD_DV)))

    qkv, c_gdn = causal_dwconv(gdn_qkv, c_gdn, p["gdn_conv_w"])
    dq, dk, dv = jnp.split(jax.nn.silu(qkv), 3, axis=-1)
    beta = jax.nn.sigmoid(gdn_b.astype(f32))
    log_a = -jnp.exp(p["gdn_a_log"].astype(f32)) * jax.nn.softplus((gdn_a + p["gdn_dt_bias"]).astype(f32))
    o, s_gdn = chunk_gated_delta(l2_normalize(split_heads(dq, GDN_DK)) * GDN_DK ** -0.5,
                                 l2_normalize(split_heads(dk, GDN_DK)), split_heads(dv, HEAD_DV), beta, log_a, s_gdn)
    o_gdn = merge_heads(rms_norm(o, p["gdn_norm_g"]) * jax.nn.silu(split_heads(gdn_z, HEAD_DV)))

    log_gamma = jnp.broadcast_to(jnp.log(1.0 - 2.0 ** (-5.0 - jnp.arange(N_HEADS, dtype=f32))), (B, T, N_HEADS))
    o, s_ret = chunk_retention(rotary(split_heads(ret_q, RET_DK), pos0),
                               rotary(split_heads(ret_k, RET_DK), pos0) * RET_DK ** -0.5,
                               split_heads(ret_v, HEAD_DV), log_gamma, s_ret)
    o_ret = merge_heads(head_layer_norm(o, p["ret_norm_g"], p["ret_norm_b"]) * jax.nn.silu(split_heads(ret_g, HEAD_DV)))

    branches = jnp.einsum("btnc,ncd->btnd", jnp.stack([o_gla, o_hg, o_gdn, o_ret], axis=2), p["w_branch"])
    gates = jax.nn.sigmoid(merge.reshape(B, T, N_BRANCH, D_MODEL))
    x = x + jnp.sum(gates * branches, axis=2) @ p["w_out"]

    h2 = rms_norm(x, p["norm_ffn_g"])
    a, u = jnp.split(h2 @ p["w_ffn_in"], 2, axis=-1)
    a, c_ffn = causal_dwconv(a, c_ffn, p["ffn_conv_w"])
    x = x + (jax.nn.silu(a + p["ffn_conv_b"]) * u) @ p["w_ffn_out"]
    return x, (s_gla, s_hg, s_gdn, s_ret, c_gdn, c_ffn)


def setup_inputs(seed: int = 0) -> dict:
    key = jax.random.key(seed)
    ks = jax.random.split(key, 32)
    nrm = jax.random.normal
    f32 = jnp.float32
    H = N_HEADS
    return {
        "x_prompt": nrm(ks[0], (BATCH, SEQ, D_MODEL), f32),
        "x_sample": nrm(ks[1], (DEC_BATCH, DEC_SEQ, D_MODEL), f32),
        "state_gla": 0.1 * nrm(ks[2], (DEPTH, DEC_BATCH, H, GLA_DK, HEAD_DV), f32),
        "state_hgrn": 0.1 * nrm(ks[3], (DEPTH, DEC_BATCH, H, HG_DK, HEAD_DV), f32),
        "state_gdn": 0.1 * nrm(ks[4], (DEPTH, DEC_BATCH, H, GDN_DK, HEAD_DV), f32),
        "state_ret": 0.1 * nrm(ks[5], (DEPTH, DEC_BATCH, H, RET_DK, HEAD_DV), f32),
        "cache_gdn_conv": nrm(ks[6], (DEPTH, DEC_BATCH, GDN_CONV - 1, GDN_QKV), f32),
        "cache_ffn_conv": nrm(ks[7], (DEPTH, DEC_BATCH, FFN_CONV - 1, D_FF), f32),
        "norm_mix_g": 1.0 + 0.02 * nrm(ks[8], (DEPTH, D_MODEL), f32),
        "w_in": nrm(ks[9], (DEPTH, D_MODEL, N_IN), f32) * D_MODEL ** -0.5,
        "gla_w_gk": nrm(ks[10], (DEPTH, GLA_LOW_RANK, H * GLA_DK), f32) * GLA_LOW_RANK ** -0.5,
        "gla_b_gk": 0.1 * nrm(ks[11], (DEPTH, H * GLA_DK), f32),
        "gla_norm_g": 1.0 + 0.02 * nrm(ks[12], (DEPTH, HEAD_DV), f32),
        "hgrn_lb_logits": 0.1 * nrm(ks[13], (DEPTH, H * HG_DK), f32),
        "hgrn_norm_g": 1.0 + 0.02 * nrm(ks[14], (DEPTH, HEAD_DV), f32),
        "gdn_conv_w": nrm(ks[15], (DEPTH, GDN_CONV, GDN_QKV), f32) * GDN_CONV ** -0.5,
        "gdn_a_log": jnp.log(jax.random.uniform(ks[16], (DEPTH, H), f32, 1.0, 16.0)),
        "gdn_dt_bias": jnp.log(jnp.expm1(jax.random.uniform(ks[17], (DEPTH, H), f32, 1e-3, 0.1))),
        "gdn_norm_g": 1.0 + 0.02 * nrm(ks[18], (DEPTH, HEAD_DV), f32),
        "ret_norm_g": 1.0 + 0.02 * nrm(ks[19], (DEPTH, HEAD_DV), f32),
        "ret_norm_b": 0.02 * nrm(ks[20], (DEPTH, HEAD_DV), f32),
        "w_branch": nrm(ks[21], (DEPTH, N_BRANCH, BRANCH_WIDTH, D_MODEL), f32) * BRANCH_WIDTH ** -0.5,
        "w_out": nrm(ks[22], (DEPTH, D_MODEL, D_MODEL), f32) * D_MODEL ** -0.5,
        "norm_ffn_g": 1.0 + 0.02 * nrm(ks[23], (DEPTH, D_MODEL), f32),
        "w_ffn_in": nrm(ks[24], (DEPTH, D_MODEL, 2 * D_FF), f32) * D_MODEL ** -0.5,
        "ffn_conv_w": nrm(ks[25], (DEPTH, FFN_CONV, D_FF), f32) * FFN_CONV ** -0.5,
        "ffn_conv_b": 0.02 * nrm(ks[26], (DEPTH, D_FF), f32),
        "w_ffn_out": nrm(ks[27], (DEPTH, D_FF, D_MODEL), f32) * D_FF ** -0.5,
        "norm_final_g": 1.0 + 0.02 * nrm(ks[28], (D_MODEL,), f32),
    }


def reference(x_prompt, x_sample, state_gla, state_hgrn, state_gdn, state_ret, cache_gdn_conv, cache_ffn_conv,
              norm_mix_g, w_in, gla_w_gk, gla_b_gk, gla_norm_g, hgrn_lb_logits, hgrn_norm_g,
              gdn_conv_w, gdn_a_log, gdn_dt_bias, gdn_norm_g, ret_norm_g, ret_norm_b,
              w_branch, w_out, norm_ffn_g, w_ffn_in, ffn_conv_w, ffn_conv_b, w_ffn_out, norm_final_g):
    lb_soft = jax.nn.softmax(hgrn_lb_logits.astype(jnp.float32), axis=0)
    lb_all = jnp.cumsum(lb_soft, axis=0) - lb_soft[0]

    dt = x_prompt.dtype
    prompt_states = (
        jnp.zeros((BATCH, N_HEADS, GLA_DK, HEAD_DV), dt),
        jnp.zeros((BATCH, N_HEADS, HG_DK, HEAD_DV), dt),
        jnp.zeros((BATCH, N_HEADS, GDN_DK, HEAD_DV), dt),
        jnp.zeros((BATCH, N_HEADS, RET_DK, HEAD_DV), dt),
        jnp.zeros((BATCH, GDN_CONV - 1, GDN_QKV), dt),
        jnp.zeros((BATCH, FFN_CONV - 1, D_FF), dt),
    )
    xp, xs = x_prompt, x_sample
    new_p, new_s = [], []
    for l in range(DEPTH):
        p = {
            "norm_mix_g": norm_mix_g[l], "w_in": w_in[l], "gla_w_gk": gla_w_gk[l], "gla_b_gk": gla_b_gk[l],
            "gla_norm_g": gla_norm_g[l], "hgrn_norm_g": hgrn_norm_g[l], "gdn_conv_w": gdn_conv_w[l],
            "gdn_a_log": gdn_a_log[l], "gdn_dt_bias": gdn_dt_bias[l], "gdn_norm_g": gdn_norm_g[l],
            "ret_norm_g": ret_norm_g[l], "ret_norm_b": ret_norm_b[l], "w_branch": w_branch[l], "w_out": w_out[l],
            "norm_ffn_g": norm_ffn_g[l], "w_ffn_in": w_ffn_in[l], "ffn_conv_w": ffn_conv_w[l],
            "ffn_conv_b": ffn_conv_b[l], "w_ffn_out": w_ffn_out[l],
        }
        xp, st_p = trunk_layer(xp, prompt_states, p, lb_all[l], 0)
        xs, st_s = trunk_layer(xs, (state_gla[l], state_hgrn[l], state_gdn[l], state_ret[l],
                                    cache_gdn_conv[l], cache_ffn_conv[l]), p, lb_all[l], PAST_LEN)
        new_p.append(st_p)
        new_s.append(st_s)
    y_prompt = rms_norm(xp, norm_final_g)
    y_sample = rms_norm(xs, norm_final_g)
    p_gla, p_hgrn, p_gdn, p_ret, p_gdn_conv, p_ffn_conv = (jnp.stack([st[i] for st in new_p]) for i in range(6))
    s_gla, s_hgrn, s_gdn, s_ret, s_gdn_conv, s_ffn_conv = (jnp.stack([st[i] for st in new_s]) for i in range(6))
    return (y_prompt, y_sample, p_gla, p_hgrn, p_gdn, p_ret, p_gdn_conv, p_ffn_conv,
            s_gla, s_hgrn, s_gdn, s_ret, s_gdn_conv, s_ffn_conv)
```

```cpp
#include <hip/hip_runtime.h>
#include <hip/hip_cooperative_groups.h>
#include <cstdio>
namespace cg = cooperative_groups;

#ifndef MK_MULTI
#define MK_MULTI 0
#endif

#define LAS __attribute__((address_space(3)))
typedef unsigned short bf16_t;
typedef short bf16x8 __attribute__((ext_vector_type(8)));
typedef float f32x4 __attribute__((ext_vector_type(4)));
typedef unsigned u32x4 __attribute__((ext_vector_type(4)));
typedef unsigned u32x2 __attribute__((ext_vector_type(2)));

constexpr int M_TOK = 18432, DM = 2048, NPROJ = 7936, NMG = 8192, DFF = 5504, NFI = 11008, NIN = 15896;
constexpr int NCHUNK = 288, NITEM = 1152;
constexpr int PROMPT_ROWS = 16384;
constexpr int C_GLA_Q = 0, C_GLA_K = 256, C_GLA_V = 512, C_GLA_G = 1024, C_HG_Q = 1536, C_HG_F = 2048, C_HG_I = 2560, C_HG_G = 3072,
              C_GDN_QKV = 3584, C_GDN_Z = 5120, C_RET_Q = 5632, C_RET_K = 6144, C_RET_V = 6656, C_RET_G = 7168, C_GLA_LR = 7680,
              C_GDN_B = 7696, C_GDN_A = 7700;
constexpr size_t SZ_WIN = (size_t)NPROJ * DM * 2, SZ_WMG = (size_t)NMG * DM * 2, SZ_WBR = (size_t)4 * DM * 512 * 2, SZ_WOUT = (size_t)DM * DM * 2,
                 SZ_WFI = (size_t)NFI * DM * 2, SZ_WFO = (size_t)DM * DFF * 2, SZ_H = (size_t)M_TOK * DM * 2;
constexpr size_t OFF_WIN = 0, OFF_WMG = OFF_WIN + SZ_WIN, OFF_WBR = OFF_WMG + SZ_WMG, OFF_WOUT = OFF_WBR + SZ_WBR, OFF_WFI = OFF_WOUT + SZ_WOUT,
                 OFF_WFO = OFF_WFI + SZ_WFI, OFF_H = OFF_WFO + SZ_WFO, OFF_OCAT = OFF_H + SZ_H, OFF_BIG = OFF_OCAT + SZ_H;
constexpr size_t OFF_PROJ = OFF_BIG, SZ_PROJ = (size_t)M_TOK * NPROJ * 2;
constexpr size_t OFF_ST_GLA = OFF_PROJ + SZ_PROJ, SZ_ST64 = (size_t)NITEM * 128 * 64 * 2, SZ_ST128 = (size_t)NITEM * 128 * 128 * 2;
constexpr size_t OFF_ST_HG = OFF_ST_GLA + SZ_ST64, OFF_ST_RET = OFF_ST_HG + SZ_ST128, OFF_ST_GDN = OFF_ST_RET + SZ_ST128, OFF_A_GDN = OFF_ST_GDN + SZ_ST128,
                 OFF_GQX = OFF_A_GDN + SZ_ST128, OFF_GO0 = OFF_GQX + SZ_ST64, OFF_DEC_GLA = OFF_GO0 + SZ_ST64, OFF_DEC_HG = OFF_DEC_GLA + (size_t)NITEM * 64 * 4,
                 OFF_MIX_END = OFF_DEC_HG + (size_t)NITEM * 128 * 4;
constexpr size_t OFF_PB = OFF_BIG;
constexpr size_t OFF_AU = OFF_BIG, OFF_PARTF = OFF_AU + (size_t)64 * 1024 * 1024  , OFF_HALO = OFF_AU + (size_t)128 * 1024 * 1024, OFF_ACT = OFF_AU + (size_t)M_TOK * NFI * 2, WS_END = OFF_ACT + (size_t)M_TOK * DFF * 2;
constexpr size_t O_YP = 0, O_YS = 33554432, O_PGLA = O_YS + 4194304, O_PHG = O_PGLA + 131072, O_PGDN = O_PHG + 262144, O_PRET = O_PGDN + 262144,
                 O_PGC = O_PRET + 262144, O_PFC = O_PGC + 18432, O_SGLA = O_PFC + 44032, O_SHG = O_SGLA + 2097152, O_SGDN = O_SHG + 4194304,
                 O_SRET = O_SGDN + 4194304, O_SGC = O_SRET + 4194304, O_SFC = O_SGC + 294912, O_END = O_SFC + 704512;
constexpr size_t OFF_BAR = WS_END, WS_TOTAL = WS_END + 16384;
constexpr int LDS_BYTES = 147456;

enum { I_XP = 0, I_XS, I_SGLA, I_SHG, I_SGDN, I_SRET, I_CGDN, I_CFFN, I_NMG, I_WIN, I_WGK, I_BGK, I_GLANG, I_LB, I_HGNG, I_GCW, I_ALOG, I_DTB, I_GDNNG,
       I_RETNG, I_RETNB, I_WBR, I_WOUT, I_NFG, I_WFI, I_FCW, I_FCB, I_WFO, I_NFIN };

struct Params { const float* in[29]; float* out; unsigned char* ws; };

typedef __bf16 bf16x2_t __attribute__((ext_vector_type(2)));
typedef float f32x2_t __attribute__((ext_vector_type(2)));
__device__ __forceinline__ unsigned cvt_pk_bf16(float lo, float hi) { f32x2_t f = {lo, hi}; bf16x2_t r = __builtin_convertvector(f, bf16x2_t); return __builtin_bit_cast(unsigned, r); }
__device__ __forceinline__ bf16_t f2bf(float f) { return (bf16_t)(cvt_pk_bf16(f, 0.f) & 0xffffu); }
__device__ __forceinline__ float bf2f(bf16_t b) { return __uint_as_float(((unsigned)b) << 16); }
__device__ __forceinline__ float bflo(unsigned w) { return __uint_as_float(w << 16); }
__device__ __forceinline__ float bfhi(unsigned w) { return __uint_as_float(w & 0xffff0000u); }
__device__ __forceinline__ void unpack8(u32x4 w, float* f) { f[0] = bflo(w[0]); f[1] = bfhi(w[0]); f[2] = bflo(w[1]); f[3] = bfhi(w[1]); f[4] = bflo(w[2]); f[5] = bfhi(w[2]); f[6] = bflo(w[3]); f[7] = bfhi(w[3]); }
__device__ __forceinline__ u32x4 pack8(const float* f) { u32x4 w; w[0] = cvt_pk_bf16(f[0], f[1]); w[1] = cvt_pk_bf16(f[2], f[3]); w[2] = cvt_pk_bf16(f[4], f[5]); w[3] = cvt_pk_bf16(f[6], f[7]); return w; }
__device__ __forceinline__ float sigm(float x) { return __builtin_amdgcn_rcpf(1.f + __expf(-x)); }
__device__ __forceinline__ float silu(float x) { return x * __builtin_amdgcn_rcpf(1.f + __expf(-x)); }
__device__ __forceinline__ float expc(float x) { return __expf(fminf(x, 80.f)); }
__device__ __forceinline__ float logsig(float x) { return fminf(x, 0.f) - log1pf(__expf(-fabsf(x))); }
__device__ __forceinline__ float softplus(float x) { return fmaxf(x, 0.f) + log1pf(__expf(-fabsf(x))); }

__device__ __forceinline__ void lds_barrier() { asm volatile("s_waitcnt lgkmcnt(0)" ::: "memory"); __builtin_amdgcn_s_barrier(); asm volatile("" ::: "memory"); }

struct ChunkInfo { int row0; int first, last, sample, b; float pos0; };
__device__ __forceinline__ ChunkInfo chunk_info(int cgi) {
    ChunkInfo c; c.row0 = cgi * 64;
    if (cgi < 256) { const int ci = cgi & 127; c.sample = 0; c.b = cgi >> 7; c.first = (ci == 0); c.last = (ci == 127); c.pos0 = (float)(ci * 64); }
    else { c.sample = 1; c.b = cgi - 256; c.first = 1; c.last = 1; c.pos0 = 4096.f; }
    return c;
}

namespace pg8 {
constexpr int BM = 256, BK = 64, HALF = 128, HTB = HALF * BK * 2, STAGE_BYTES = 8 * HTB, NXCD = 8, WGM = 8;
__device__ __forceinline__ int lds_byte(int r, int c) { const int st = (r >> 4) * 2 + (c >> 5), rr = r & 15, cc = c & 31, ob = rr * 64 + cc * 2; return st * 1024 + (ob ^ (((ob >> 9) & 1) << 5)); }
__device__ __forceinline__ void stage_rc(int b, int& R, int& C) { const int st = b / 1024, sb = b % 1024, swz = sb ^ (((sb >> 9) & 1) << 5); R = (st >> 1) * 16 + swz / 64; C = (st & 1) * 32 + (swz % 64) / 2; }
__device__ __forceinline__ int perm32(int rho) { const int n = rho >> 4, i = rho & 15; return 8 * (i >> 2) + 4 * n + (i & 3); }
struct Unit { int pm, pn, aux, nt; const char* a; const char* b; };
__device__ __forceinline__ void tile_of(int L, int nM, int nN, int& pm, int& pn) {
    const int nwg = nM * nN; int wgid = L;
    { const int q = nwg / NXCD, r = nwg % NXCD, xcd = wgid % NXCD, off = wgid / NXCD; wgid = (xcd < r ? xcd * (q + 1) : r * (q + 1) + (xcd - r) * q) + off; }
    const int nig = WGM * nN, gid = wgid / nig, fm = gid * WGM, gsz = (nM - fm) < WGM ? (nM - fm) : WGM;
    pm = fm + ((wgid % nig) % gsz); pn = (wgid % nig) / gsz;
}
struct TileOrder {
    const char* A; const char* B; int lda, ldb, nM, nN, G, c, nt;
    __device__ __forceinline__ bool next(int i, Unit& u) const {
        const long L = (long)i * G + c; if (L >= (long)nM * nN) return false;
        tile_of((int)L, nM, nN, u.pm, u.pn); u.aux = 0; u.nt = nt;
        u.a = A + (size_t)u.pm * 256 * lda * 2; u.b = B + (size_t)u.pn * 256 * ldb * 2; return true;
    }
};
struct BranchOrder {
    const char* A; const char* B; int nM, nN, G, c;
    __device__ __forceinline__ bool next(int i, Unit& u) const {
        const long L = (long)i * G + c; if (L >= (long)nM * nN) return false;
        tile_of((int)L, nM, nN, u.pm, u.pn); u.aux = 0; u.nt = 8;
        const int n = u.pn >> 3, pn = u.pn & 7;
        u.a = A + ((size_t)u.pm * 256 * DM + (size_t)n * 512) * 2; u.b = B + ((size_t)n * DM * 512 + (size_t)pn * 256 * 512) * 2; return true;
    }
};

struct SplitOrder {
    const char* A; const char* B; int lda, ldb, G, c, nt;
    __device__ __forceinline__ bool next(int i, Unit& u) const {
        if (G != 256) { const long L = (long)i * G + c; if (L >= 576) return false; tile_of((int)L, 72, 8, u.pm, u.pn); u.aux = 0; u.nt = nt;
            u.a = A + (size_t)u.pm * 256 * lda * 2; u.b = B + (size_t)u.pn * 256 * ldb * 2; return true; }
        if (i < 2) { tile_of(i * 256 + c, 64, 8, u.pm, u.pn); u.aux = 0; u.nt = nt; u.a = A + (size_t)u.pm * 256 * lda * 2; u.b = B + (size_t)u.pn * 256 * ldb * 2; return true; }
        if (i > 2) return false;
        const int j = c >> 2, q = c & 3, per = ((nt / 4 + 1) / 2) * 2, kt0 = q * per;
        u.pm = 64 + (j >> 3); u.pn = j & 7; u.aux = 1 + q; u.nt = min(per, nt - kt0);
        u.a = A + (size_t)u.pm * 256 * lda * 2 + (size_t)kt0 * 128; u.b = B + (size_t)u.pn * 256 * ldb * 2 + (size_t)kt0 * 128; return true;
    }
};

constexpr int FFN_SPLIT_PM0 = 48, FFN_SPLIT_PN = 42;
struct FfnOrder {
    const char* A; const char* B; int G, c;
    __device__ __forceinline__ bool next(int i, Unit& u) const {
        if (G != 256) { const long L = (long)i * G + c; if (L >= 72 * 43) return false; tile_of((int)L, 72, 43, u.pm, u.pn); u.aux = 0; u.nt = DM / 64;
            u.a = A + (size_t)u.pm * 256 * DM * 2; u.b = B + (size_t)u.pn * 256 * DM * 2; return true; }
        if (i < 12) { const int L = i * 256 + c;
            if (L < 72 * 42) tile_of(L, 72, 42, u.pm, u.pn); else { u.pm = L - 72 * 42; u.pn = FFN_SPLIT_PN; }
            u.aux = 0; u.nt = DM / 64; u.a = A + (size_t)u.pm * 256 * DM * 2; u.b = B + (size_t)u.pn * 256 * DM * 2; return true; }
        if (i > 12 || c >= 96) return false;
        const int j = c >> 2, q = c & 3;
        u.pm = FFN_SPLIT_PM0 + j; u.pn = FFN_SPLIT_PN; u.aux = 1 + q; u.nt = 8;
        u.a = A + (size_t)u.pm * 256 * DM * 2 + (size_t)q * 8 * 128; u.b = B + (size_t)u.pn * 256 * DM * 2 + (size_t)q * 8 * 128; return true;
    }
};

template <class Epi, class Sched>
__device__ __forceinline__ void gemm_phase(LAS unsigned char* lds, const int lda, const int ldb, const int K, const Sched& S, const Epi& E) {
    const int tid = threadIdx.x, wid = __builtin_amdgcn_readfirstlane(tid >> 6), lane = tid & 63, wr = wid >> 2, wc = wid & 3, fr = lane & 15, fq = lane >> 4;
    unsigned voffA[2], voffB[2];
#pragma unroll
    for (int i = 0; i < 2; ++i) { int R, C; stage_rc(tid * 16 + i * 8192, R, C); const int Rb = Epi::PERM ? ((R & ~31) + perm32(R & 31)) : R;
        voffA[i] = (unsigned)(R * lda + C) * 2u; voffB[i] = (unsigned)(Rb * ldb + C) * 2u; }
    const size_t kstep = (size_t)(BK * 2);
    const size_t hstepA = (size_t)HALF * lda * 2, hstepB = (size_t)HALF * ldb * 2;
    const unsigned ldsw = (unsigned)wid * 1024u;
    const int aoff = lds_byte(wr * 64 + fr, fq * 8), boff = lds_byte(wc * 32 + fr, fq * 8);
#define PG8_SA(b, h) (((b) * 2 + (h)) * HTB)
#define PG8_SB(b, h) ((4 + (b) * 2 + (h)) * HTB)
#define PG8_STAGE(bufoff, gbase, voff) do { _Pragma("unroll") for (int _i = 0; _i < 2; ++_i) \
        __builtin_amdgcn_global_load_lds((const unsigned*)((const char*)(gbase) + (voff)[_i]), (LAS unsigned*)(lds + (bufoff) + ldsw + _i * 8192), 16, 0, 0); } while (0)
#define PG8_LDA(dst, b, h) do { _Pragma("unroll") for (int m = 0; m < 4; ++m) _Pragma("unroll") for (int k = 0; k < 2; ++k) dst[m][k] = *(const LAS bf16x8*)(lds + PG8_SA(b, h) + aoff + m * 2048 + k * 1024); } while (0)
#define PG8_LDB(dst, b, h) do { _Pragma("unroll") for (int n = 0; n < 2; ++n) _Pragma("unroll") for (int k = 0; k < 2; ++k) dst[n][k] = *(const LAS bf16x8*)(lds + PG8_SB(b, h) + boff + n * 2048 + k * 1024); } while (0)
#define PG8_MMA(ai, bj, At, Bt) do { __builtin_amdgcn_s_setprio(1); _Pragma("unroll") for (int m = 0; m < 4; ++m) _Pragma("unroll") for (int n = 0; n < 2; ++n) _Pragma("unroll") for (int k = 0; k < 2; ++k) \
        acc[ai][bj][m][n] = __builtin_amdgcn_mfma_f32_16x16x32_bf16(Bt[n][k], At[m][k], acc[ai][bj][m][n], 0, 0, 0); __builtin_amdgcn_s_setprio(0); } while (0)
#define PG8_WAIT_V(n) asm volatile("s_waitcnt vmcnt(" #n ")" ::: "memory")
#define PG8_WAIT_L(n) asm volatile("s_waitcnt lgkmcnt(" #n ")" ::: "memory")
#define PG8_BAR __builtin_amdgcn_s_barrier()
#define PG8_SCHED __builtin_amdgcn_sched_barrier(0)
    Unit cur, nxt; int ui = 0;
    if (!S.next(0, cur)) return;
    f32x4 acc[2][2][4][2];
#pragma unroll
    for (int a = 0; a < 2; ++a)
#pragma unroll
        for (int b = 0; b < 2; ++b)
#pragma unroll
            for (int m = 0; m < 4; ++m)
#pragma unroll
                for (int n = 0; n < 2; ++n) acc[a][b][m][n] = (f32x4){0.f, 0.f, 0.f, 0.f};
    bf16x8 At[4][2], B0[2][2], B1[2][2];
    const char* cA = cur.a; const char* cB = cur.b;
    PG8_STAGE(PG8_SB(0, 0), cB, voffB); PG8_STAGE(PG8_SA(0, 0), cA, voffA); PG8_STAGE(PG8_SB(0, 1), cB + hstepB, voffB); PG8_STAGE(PG8_SA(0, 1), cA + hstepA, voffA);
    if (wr == 1) PG8_BAR;
    PG8_WAIT_V(4); PG8_BAR;
    PG8_STAGE(PG8_SB(1, 0), cB + kstep, voffB); PG8_STAGE(PG8_SA(1, 0), cA + kstep, voffA); PG8_STAGE(PG8_SB(1, 1), cB + hstepB + kstep, voffB);
    PG8_WAIT_V(6); PG8_BAR;
    for (;;) {
        const bool has_next = S.next(ui + 1, nxt);
        const char* nA = has_next ? nxt.a : cA; const char* nB = has_next ? nxt.b : cB;
        const int cnt = cur.nt;
        for (int t = 0; t < cnt; t += 2) {
            const bool last = (t == cnt - 2);
            const char* a1 = cA + (size_t)(t + 1) * kstep;
            const char* a2 = last ? nA : cA + (size_t)(t + 2) * kstep; const char* b2 = last ? nB : cB + (size_t)(t + 2) * kstep;
            const char* a3 = a2 + kstep; const char* b3 = b2 + kstep;
            PG8_LDB(B0, 0, 0); PG8_SCHED; PG8_LDA(At, 0, 0); PG8_STAGE(PG8_SA(1, 1), a1 + hstepA, voffA);
            PG8_WAIT_L(8); PG8_BAR; PG8_WAIT_L(0); PG8_MMA(0, 0, At, B0); PG8_BAR; PG8_SCHED;
            PG8_LDB(B1, 0, 1); PG8_STAGE(PG8_SB(0, 0), b2, voffB);
            PG8_BAR; PG8_WAIT_L(0); PG8_MMA(0, 1, At, B1); PG8_BAR;
            PG8_LDA(At, 0, 1); PG8_STAGE(PG8_SA(0, 0), a2, voffA);
            PG8_BAR; PG8_WAIT_L(0); PG8_MMA(1, 0, At, B0); PG8_BAR; PG8_SCHED;
            PG8_STAGE(PG8_SB(0, 1), b2 + hstepB, voffB);
            PG8_WAIT_V(6); PG8_BAR; PG8_MMA(1, 1, At, B1); PG8_BAR;
            PG8_LDB(B0, 1, 0); PG8_SCHED; PG8_LDA(At, 1, 0); PG8_STAGE(PG8_SA(0, 1), a2 + hstepA, voffA);
            PG8_WAIT_L(8); PG8_BAR; PG8_WAIT_L(0); PG8_MMA(0, 0, At, B0); PG8_BAR; PG8_SCHED;
            PG8_LDB(B1, 1, 1); PG8_STAGE(PG8_SB(1, 0), b3, voffB);
            PG8_BAR; PG8_WAIT_L(0); PG8_MMA(0, 1, At, B1); PG8_BAR;
            PG8_LDA(At, 1, 1); PG8_STAGE(PG8_SA(1, 0), a3, voffA);
            PG8_BAR; PG8_WAIT_L(0); PG8_MMA(1, 0, At, B0); PG8_BAR; PG8_SCHED;
            PG8_STAGE(PG8_SB(1, 1), b3 + hstepB, voffB);
            PG8_WAIT_V(6); PG8_BAR; PG8_MMA(1, 1, At, B1); PG8_BAR;
        }
        E(acc, cur, wr, wc, fr, fq);
        if (!has_next) break;
#pragma unroll
        for (int a = 0; a < 2; ++a)
#pragma unroll
            for (int b = 0; b < 2; ++b)
#pragma unroll
                for (int m = 0; m < 4; ++m)
#pragma unroll
                    for (int n = 0; n < 2; ++n) acc[a][b][m][n] = (f32x4){0.f, 0.f, 0.f, 0.f};
        cur = nxt; cA = nA; cB = nB; ++ui;
    }
    PG8_WAIT_V(0);
    if (wr == 0) PG8_BAR;
    PG8_BAR;
#undef PG8_SA
#undef PG8_SB
#undef PG8_STAGE
#undef PG8_LDA
#undef PG8_LDB
#undef PG8_MMA
#undef PG8_WAIT_V
#undef PG8_WAIT_L
#undef PG8_BAR
#undef PG8_SCHED
}

template <int ACT> struct EpiBf16 {
    static constexpr bool PERM = true;
    bf16_t* O; int ldc;
    __device__ __forceinline__ void operator()(const f32x4 (&acc)[2][2][4][2], const Unit& u, int wr, int wc, int fr, int fq) const {
        const int row0 = u.pm * BM + wr * 64 + fr, col0 = u.pn * BM + wc * 32 + 8 * fq;
#pragma unroll
        for (int ai = 0; ai < 2; ++ai)
#pragma unroll
            for (int m = 0; m < 4; ++m) { bf16_t* rowp = O + (size_t)(row0 + ai * HALF + m * 16) * ldc + col0;
#pragma unroll
                for (int bj = 0; bj < 2; ++bj) { f32x4 v0 = acc[ai][bj][m][0], v1 = acc[ai][bj][m][1];
                    if (ACT == 1) { for (int j = 0; j < 4; ++j) { v0[j] = sigm(v0[j]); v1[j] = sigm(v1[j]); } }
                    u32x4 w; w[0] = cvt_pk_bf16(v0[0], v0[1]); w[1] = cvt_pk_bf16(v0[2], v0[3]); w[2] = cvt_pk_bf16(v1[0], v1[1]); w[3] = cvt_pk_bf16(v1[2], v1[3]);
                    *(u32x4*)(rowp + bj * HALF) = w; } }
    }
};
struct EpiMerge {
    static constexpr bool PERM = true;
    const bf16_t* pb; bf16_t* mixed;
    __device__ __forceinline__ void operator()(const f32x4 (&acc)[2][2][4][2], const Unit& u, int wr, int wc, int fr, int fq) const {
        const int row0 = u.pm * BM + wr * 64 + fr, d0 = u.pn * 64 + wc * 16 + fq * 4;
        u32x2 pw[2][4][4];
#pragma unroll
        for (int ai = 0; ai < 2; ++ai)
#pragma unroll
            for (int m = 0; m < 4; ++m)
#pragma unroll
                for (int n = 0; n < 4; ++n) pw[ai][m][n] = *(const u32x2*)(pb + (size_t)(row0 + ai * HALF + m * 16) * NMG + n * DM + d0);
#pragma unroll
        for (int ai = 0; ai < 2; ++ai)
#pragma unroll
            for (int m = 0; m < 4; ++m) { const size_t row = (size_t)(row0 + ai * HALF + m * 16);
                float o[4] = {0.f, 0.f, 0.f, 0.f};
#pragma unroll
                for (int n = 0; n < 4; ++n) { const f32x4 a = acc[ai][n >> 1][m][n & 1]; const u32x2 w = pw[ai][m][n];
                    o[0] += sigm(a[0]) * bflo(w[0]); o[1] += sigm(a[1]) * bfhi(w[0]); o[2] += sigm(a[2]) * bflo(w[1]); o[3] += sigm(a[3]) * bfhi(w[1]); }
                u32x2 w; w[0] = cvt_pk_bf16(o[0], o[1]); w[1] = cvt_pk_bf16(o[2], o[3]);
                *(u32x2*)(mixed + row * DM + d0) = w; }
    }
};
__device__ __forceinline__ float dpp_ror1(float x) { return __builtin_bit_cast(float, __builtin_amdgcn_mov_dpp(__builtin_bit_cast(int, x), 0x121, 0xF, 0xF, true)); }
__device__ __forceinline__ float dpp_ror2(float x) { return __builtin_bit_cast(float, __builtin_amdgcn_mov_dpp(__builtin_bit_cast(int, x), 0x122, 0xF, 0xF, true)); }
struct EpiFfn {
    static constexpr bool PERM = true;
    bf16_t* act; bf16_t* halo; const float* cw; const float* cb; float* partf;
    __device__ __forceinline__ void operator()(const f32x4 (&acc)[2][2][4][2], const Unit& u, int wr, int wc, int fr, int fq) const {
        if (u.aux) {
            float* pq = partf + ((size_t)(u.aux - 1) * 24 + (u.pm - FFN_SPLIT_PM0)) * 65536;
#pragma unroll
            for (int ai = 0; ai < 2; ++ai)
#pragma unroll
                for (int m = 0; m < 4; ++m)
#pragma unroll
                    for (int bj = 0; bj < 2; ++bj)
#pragma unroll
                        for (int n = 0; n < 2; ++n) *(f32x4*)(pq + (size_t)(ai * HALF + wr * 64 + 16 * m + fr) * 256 + bj * HALF + wc * 32 + 8 * fq + 4 * n) = acc[ai][bj][m][n];
            return;
        }
        const int j0 = u.pn * 128 + wc * 32 + 8 * fq;
        float w0[8], w1[8], w2[8], bb[8];
#pragma unroll
        for (int c = 0; c < 8; c += 4) { const float4 a = *(const float4*)(cw + j0 + c), b = *(const float4*)(cw + DFF + j0 + c), d = *(const float4*)(cw + 2 * DFF + j0 + c), e = *(const float4*)(cb + j0 + c);
            w0[c] = a.x; w0[c + 1] = a.y; w0[c + 2] = a.z; w0[c + 3] = a.w; w1[c] = b.x; w1[c + 1] = b.y; w1[c + 2] = b.z; w1[c + 3] = b.w;
            w2[c] = d.x; w2[c + 1] = d.y; w2[c + 2] = d.z; w2[c + 3] = d.w; bb[c] = e.x; bb[c + 1] = e.y; bb[c + 2] = e.z; bb[c + 3] = e.w; }
#pragma unroll
        for (int ai = 0; ai < 2; ++ai) {
            const int R0 = u.pm * BM + ai * HALF + wr * 64, cgi = R0 >> 6;
            float p1[8], p2[8];
#pragma unroll
            for (int e = 0; e < 8; ++e) { p1[e] = 0.f; p2[e] = 0.f; }
#pragma unroll
            for (int m = 0; m < 4; ++m) {
                const size_t row = (size_t)(R0 + 16 * m + fr);
                float y[8], ac[8], uc[8];
#pragma unroll
                for (int e = 0; e < 8; ++e) {
                    const float a = acc[ai][0][m][e >> 2][e & 3], uu = acc[ai][1][m][e >> 2][e & 3];
                    const float r1c = dpp_ror1(a), r2c = dpp_ror2(a);
                    const float a1 = (fr >= 1) ? r1c : p1[e], a2 = (fr >= 2) ? r2c : p2[e];
                    p1[e] = r1c; p2[e] = r2c;
                    y[e] = silu(w0[e] * a2 + w1[e] * a1 + w2[e] * a + bb[e]) * uu; ac[e] = a; uc[e] = uu;
                }
                if (m > 0 || fr >= 2) *(u32x4*)(act + row * DFF + j0) = pack8(y);
                const int slot = (m == 0 && fr < 2) ? fr : ((m == 3 && fr >= 14) ? fr - 12 : -1);
                if (slot >= 0) { bf16_t* hp = halo + ((size_t)(cgi * 4 + slot) * 2) * DFF + j0; *(u32x4*)hp = pack8(ac); *(u32x4*)(hp + DFF) = pack8(uc); }
            }
        }
    }
};
struct EpiResid {
    static constexpr bool PERM = false;
    const float* xin_p; const float* xin_s; float* xout; float* part;
    __device__ __forceinline__ void operator()(const f32x4 (&acc)[2][2][4][2], const Unit& u, int wr, int wc, int fr, int fq) const {
        const int row0 = u.pm * BM + wr * 64 + fr, col0 = u.pn * BM + wc * 32 + 4 * fq;
        if (u.aux == 0) {
            const float* xin = (u.pm * BM < PROMPT_ROWS) ? xin_p : (xin_s - (size_t)PROMPT_ROWS * DM);
#pragma unroll
            for (int ai = 0; ai < 2; ++ai) {
                f32x4 xv[4][2][2];
#pragma unroll
                for (int m = 0; m < 4; ++m)
#pragma unroll
                    for (int bj = 0; bj < 2; ++bj)
#pragma unroll
                        for (int n = 0; n < 2; ++n) xv[m][bj][n] = *(const f32x4*)(xin + (size_t)(row0 + ai * HALF + m * 16) * DM + col0 + bj * HALF + n * 16);
#pragma unroll
                for (int m = 0; m < 4; ++m)
#pragma unroll
                    for (int bj = 0; bj < 2; ++bj)
#pragma unroll
                        for (int n = 0; n < 2; ++n) *(f32x4*)(xout + (size_t)(row0 + ai * HALF + m * 16) * DM + col0 + bj * HALF + n * 16) = acc[ai][bj][m][n] + xv[m][bj][n];
            }
        } else {
            float* pq = part + (size_t)(u.aux - 1) * 2048 * DM - (size_t)PROMPT_ROWS * DM;
#pragma unroll
            for (int ai = 0; ai < 2; ++ai)
#pragma unroll
                for (int m = 0; m < 4; ++m) { const size_t ro = (size_t)(row0 + ai * HALF + m * 16) * DM + col0;
#pragma unroll
                    for (int bj = 0; bj < 2; ++bj)
#pragma unroll
                        for (int n = 0; n < 2; ++n) *(f32x4*)(pq + ro + bj * HALF + n * 16) = acc[ai][bj][m][n]; }
        }
    }
};
}

template <class F>
__device__ __forceinline__ void lds_mm(const LAS bf16_t* X, int ldx, const LAS bf16_t* Y, int ldy, int MB, int NB, int ksteps, F&& epi) {
    int tidl = threadIdx.x; asm volatile("" : "+v"(tidl));
    const int wid = tidl >> 6, lane = tidl & 63, fr = lane & 15, fq = lane >> 4;
    for (int blk = wid; blk < MB * NB; blk += 8) {
        const int mb = blk / NB, nb = blk - mb * NB;
        f32x4 a00 = {0.f, 0.f, 0.f, 0.f}, a01 = a00, a10 = a00, a11 = a00;
        const LAS bf16_t* xp = X + (mb * 32 + fr) * ldx + fq * 8;
        const LAS bf16_t* yp = Y + (nb * 32 + fr) * ldy + fq * 8;
        for (int k = 0; k < ksteps; ++k) {
            const bf16x8 x0 = *(const LAS bf16x8*)(xp + k * 32), x1 = *(const LAS bf16x8*)(xp + 16 * ldx + k * 32);
            const bf16x8 y0 = *(const LAS bf16x8*)(yp + k * 32), y1 = *(const LAS bf16x8*)(yp + 16 * ldy + k * 32);
            a00 = __builtin_amdgcn_mfma_f32_16x16x32_bf16(y0, x0, a00, 0, 0, 0);
            a01 = __builtin_amdgcn_mfma_f32_16x16x32_bf16(y1, x0, a01, 0, 0, 0);
            a10 = __builtin_amdgcn_mfma_f32_16x16x32_bf16(y0, x1, a10, 0, 0, 0);
            a11 = __builtin_amdgcn_mfma_f32_16x16x32_bf16(y1, x1, a11, 0, 0, 0);
        }
        const int r = mb * 32 + fr, c = nb * 32 + fq * 4;
        epi(r, c, a00); epi(r, c + 16, a01); epi(r + 16, c, a10); epi(r + 16, c + 16, a11);
    }
}

__device__ __forceinline__ int merge_row(int cidx) { const int n = cidx >> 11, d = cidx & 2047, dl = d & 63; return (d >> 6) * 256 + (n >> 1) * 128 + (dl >> 4) * 32 + ((dl >> 2) & 3) * 8 + (n & 1) * 4 + (dl & 3); }
template <int MAP = 0>
__device__ __forceinline__ void conv_job(const float* __restrict__ src, int sld, int K, int scol0, int ncols, bf16_t* dst, int dld, int drow0, LAS unsigned* tl, int& rot, int first = 0, int cnt = 0) {
    const int nk = K / 64, nn = (ncols + 63) / 64, ntiles = nk * nn, G = cnt ? cnt : (int)gridDim.x, tid = threadIdx.x;
    const int kp = tid >> 4, n4 = (tid & 15) * 4, on = tid >> 3, okg = tid & 7;
    int t = ((int)blockIdx.x - first + G - rot) % G;
    float4 r0 = make_float4(0.f, 0.f, 0.f, 0.f), r1 = r0;
    if (t < ntiles) { const int tk = t / nn, tn = t - tk * nn;
        if (n4 < min(64, ncols - tn * 64)) { const float* sp = src + (size_t)(tk * 64 + 2 * kp) * sld + scol0 + tn * 64 + n4; r0 = *(const float4*)sp; r1 = *(const float4*)(sp + sld); } }
    for (; t < ntiles; t += G) {
        const int tk = t / nn, tn = t - tk * nn, k0 = tk * 64, n0 = tn * 64, nvalid = min(64, ncols - n0);
        tl[(n4 + 0) * 33 + kp] = cvt_pk_bf16(r0.x, r1.x); tl[(n4 + 1) * 33 + kp] = cvt_pk_bf16(r0.y, r1.y);
        tl[(n4 + 2) * 33 + kp] = cvt_pk_bf16(r0.z, r1.z); tl[(n4 + 3) * 33 + kp] = cvt_pk_bf16(r0.w, r1.w);
        lds_barrier();
        { const int t2 = t + G; r0 = make_float4(0.f, 0.f, 0.f, 0.f); r1 = r0;
          if (t2 < ntiles) { const int tk2 = t2 / nn, tn2 = t2 - tk2 * nn;
              if (n4 < min(64, ncols - tn2 * 64)) { const float* sp = src + (size_t)(tk2 * 64 + 2 * kp) * sld + scol0 + tn2 * 64 + n4; r0 = *(const float4*)sp; r1 = *(const float4*)(sp + sld); } } }
        if (on < nvalid) { u32x4 v; v[0] = tl[on * 33 + okg * 4]; v[1] = tl[on * 33 + okg * 4 + 1]; v[2] = tl[on * 33 + okg * 4 + 2]; v[3] = tl[on * 33 + okg * 4 + 3];
            int drow = drow0 + n0 + on;
            if (MAP == 1) drow = merge_row(n0 + on);
            if (MAP == 2) { const int sc = n0 + on, j = sc < DFF ? sc : sc - DFF; drow = (j >> 7) * 256 + (sc < DFF ? 0 : 128) + (j & 127); }
            *(u32x4*)(dst + (size_t)drow * dld + k0 + okg * 8) = v; }
        lds_barrier();
    }
    rot = (rot + ntiles) % G;
}

__device__ __forceinline__ float wave_sum(float v) {
#pragma unroll
    for (int o = 32; o >= 1; o >>= 1) v += __shfl_xor(v, o);
    return v;
}

template <bool FINAL>
__device__ __forceinline__ void norm_rows(const float* xp, const float* xs, const float* __restrict__ g, bf16_t* h, float* yout, const float* part, float* xwb) {
    const int wid = threadIdx.x >> 6;
    for (int r = blockIdx.x * 8 + wid; r < M_TOK; r += gridDim.x * 8) {
        int lane = threadIdx.x & 63; asm volatile("" : "+v"(lane));
        const float* xr = (r < PROMPT_ROWS) ? xp + (size_t)r * DM : xs + (size_t)(r - PROMPT_ROWS) * DM;
        float4 v[8], gv[8]; float ss = 0.f;
#pragma unroll
        for (int j = 0; j < 8; ++j) v[j] = *(const float4*)(xr + (j * 64 + lane) * 4);
#pragma unroll
        for (int j = 0; j < 8; ++j) gv[j] = *(const float4*)(g + (j * 64 + lane) * 4);
        if (part != nullptr && r >= PROMPT_ROWS) {
#pragma unroll
            for (int q = 0; q < 4; ++q) { const float* pr = part + ((size_t)q * 2048 + (r - PROMPT_ROWS)) * DM;
#pragma unroll
                for (int j = 0; j < 8; ++j) { const float4 a = *(const float4*)(pr + (j * 64 + lane) * 4); v[j].x += a.x; v[j].y += a.y; v[j].z += a.z; v[j].w += a.w; } }
            if (xwb != nullptr) {
#pragma unroll
                for (int j = 0; j < 8; ++j) *(float4*)(xwb + (size_t)r * DM + (j * 64 + lane) * 4) = v[j]; }
        }
#pragma unroll
        for (int j = 0; j < 8; ++j) ss += v[j].x * v[j].x + v[j].y * v[j].y + v[j].z * v[j].z + v[j].w * v[j].w;
        ss = wave_sum(ss);
        const float rs = rsqrtf(ss * (1.f / DM) + 1e-6f);
#pragma unroll
        for (int j = 0; j < 8; ++j) { const int c = (j * 64 + lane) * 4;
            const float o0 = v[j].x * rs * gv[j].x, o1 = v[j].y * rs * gv[j].y, o2 = v[j].z * rs * gv[j].z, o3 = v[j].w * rs * gv[j].w;
            if (FINAL) *(float4*)(yout + (size_t)r * DM + c) = make_float4(o0, o1, o2, o3);
            else { u32x2 w; w[0] = cvt_pk_bf16(o0, o1); w[1] = cvt_pk_bf16(o2, o3); *(u32x2*)(h + (size_t)r * DM + c) = w; } }
    }
}

template <bool FINAL = false>
__device__ __forceinline__ void norm_rows2(const float* xp, const float* xs, const float* __restrict__ g, bf16_t* h, const float* part, float* xwb, float* yout = nullptr) {
    const int wid = threadIdx.x >> 6, nw = gridDim.x * 8;
    for (int r0 = blockIdx.x * 8 + wid; r0 < M_TOK; r0 += 2 * nw) {
        int lane = threadIdx.x & 63; asm volatile("" : "+v"(lane));
        const int r1 = r0 + nw; const bool ok1 = r1 < M_TOK; const int r1c = ok1 ? r1 : r0;
        const float* xa = (r0 < PROMPT_ROWS) ? xp + (size_t)r0 * DM : xs + (size_t)(r0 - PROMPT_ROWS) * DM;
        const float* xb = (r1c < PROMPT_ROWS) ? xp + (size_t)r1c * DM : xs + (size_t)(r1c - PROMPT_ROWS) * DM;
        float4 va[8], vb[8], gv[8];
#pragma unroll
        for (int j = 0; j < 8; ++j) { va[j] = *(const float4*)(xa + (j * 64 + lane) * 4); vb[j] = *(const float4*)(xb + (j * 64 + lane) * 4); }
#pragma unroll
        for (int j = 0; j < 8; ++j) gv[j] = *(const float4*)(g + (j * 64 + lane) * 4);
#pragma unroll
        for (int q = 0; q < 2; ++q) {
            const int r = q ? r1c : r0;
            if (q == 0 || ok1) {
                float4 v[8];
#pragma unroll
                for (int j = 0; j < 8; ++j) v[j] = q ? vb[j] : va[j];
                if (part != nullptr && r >= PROMPT_ROWS) {
#pragma unroll
                    for (int pq = 0; pq < 4; ++pq) { const float* pr = part + ((size_t)pq * 2048 + (r - PROMPT_ROWS)) * DM;
#pragma unroll
                        for (int j = 0; j < 8; ++j) { const float4 a = *(const float4*)(pr + (j * 64 + lane) * 4); v[j].x += a.x; v[j].y += a.y; v[j].z += a.z; v[j].w += a.w; } }
                    if (xwb != nullptr) {
#pragma unroll
                        for (int j = 0; j < 8; ++j) *(float4*)(xwb + (size_t)r * DM + (j * 64 + lane) * 4) = v[j]; }
                }
                float ss = 0.f;
#pragma unroll
                for (int j = 0; j < 8; ++j) ss += v[j].x * v[j].x + v[j].y * v[j].y + v[j].z * v[j].z + v[j].w * v[j].w;
                ss = wave_sum(ss);
                const float rs = rsqrtf(ss * (1.f / DM) + 1e-6f);
#pragma unroll
                for (int j = 0; j < 8; ++j) { const int c = (j * 64 + lane) * 4;
                    if (FINAL) *(float4*)(yout + (size_t)r * DM + c) = make_float4(v[j].x * rs * gv[j].x, v[j].y * rs * gv[j].y, v[j].z * rs * gv[j].z, v[j].w * rs * gv[j].w);
                    else { u32x2 w; w[0] = cvt_pk_bf16(v[j].x * rs * gv[j].x, v[j].y * rs * gv[j].y); w[1] = cvt_pk_bf16(v[j].z * rs * gv[j].z, v[j].w * rs * gv[j].w);
                        *(u32x2*)(h + (size_t)r * DM + c) = w; } }
            }
        }
    }
}

__device__ __forceinline__ void phase_prep(const Params& p, int l, LAS unsigned char* lds) {
    unsigned char* ws = p.ws; LAS unsigned* tl = (LAS unsigned*)lds; int rot = 0;
    const float* win = p.in[I_WIN] + (size_t)l * DM * NIN;
    bf16_t* WIN = (bf16_t*)(ws + OFF_WIN);
    conv_job(win, NIN, DM, 0, 1536, WIN, DM, 0, tl, rot);
    conv_job(win, NIN, DM, 1552, 2048, WIN, DM, 1536, tl, rot);
    conv_job(win, NIN, DM, 3600, 2048, WIN, DM, 3584, tl, rot);
    conv_job(win, NIN, DM, 5656, 2048, WIN, DM, 5632, tl, rot);
    conv_job(win, NIN, DM, 1536, 16, WIN, DM, 7680, tl, rot);
    conv_job(win, NIN, DM, 5648, 8, WIN, DM, 7696, tl, rot);
    conv_job<1>(win, NIN, DM, 7704, 8192, (bf16_t*)(ws + OFF_WMG), DM, 0, tl, rot);
    for (int n = 0; n < 4; ++n) conv_job(p.in[I_WBR] + ((size_t)l * 4 + n) * 512 * DM, DM, 512, 0, DM, (bf16_t*)(ws + OFF_WBR) + (size_t)n * DM * 512, 512, 0, tl, rot);
    {
        u32x4* z = (u32x4*)(WIN + (size_t)7704 * DM); const int n16 = (NPROJ - 7704) * DM * 2 / 16;
        for (int i = blockIdx.x * 512 + threadIdx.x; i < n16; i += gridDim.x * 512) z[i] = (u32x4){0u, 0u, 0u, 0u};
    }
    if (l == 0) norm_rows2(p.in[I_XP], p.in[I_XS], p.in[I_NMG], (bf16_t*)(ws + OFF_H), nullptr, nullptr);
    else norm_rows2(p.out, p.out + O_YS, p.in[I_NMG] + DM, (bf16_t*)(ws + OFF_H), (const float*)(ws + OFF_BIG), p.out);
}

constexpr int LA_QT = 0, LA_KT = 17408, LA_KH = 34816, LA_VT = 53248, LA_ATT = 71680, LA_BB = 80896;
constexpr int LDQ = 136, LDT = 72, LDBB = 132;

struct LinRegs { u32x4 q0, q1, k0, k1, v0, v1, l0, l1; };
template <int MODE>
__device__ __forceinline__ void lin_load(const Params& p, int cgi, int h, int tid, LinRegs& R) {
    constexpr int K = (MODE == 0) ? 64 : 128, KPT = K / 8;
    constexpr int CQ = (MODE == 0) ? C_GLA_Q : (MODE == 1 ? C_HG_Q : C_RET_Q), CK = (MODE == 0) ? C_GLA_K : (MODE == 1 ? C_HG_F : C_RET_K),
                  CV = (MODE == 0) ? C_GLA_V : (MODE == 1 ? C_HG_I : C_RET_V);
    const int t = tid >> 3, sub = tid & 7, k0 = sub * KPT;
    const bf16_t* prow = (const bf16_t*)(p.ws + OFF_PROJ) + (size_t)(cgi * 64 + t) * NPROJ;
    const u32x4 z4 = {0u, 0u, 0u, 0u}; R.q0 = z4; R.q1 = z4; R.k0 = z4; R.k1 = z4; R.l0 = z4; R.l1 = z4;
    if (MODE == 0) { R.q0 = *(const u32x4*)(prow + CQ + h * 64 + k0); R.k0 = *(const u32x4*)(prow + CK + h * 64 + k0); R.l0 = *(const u32x4*)(prow + C_GLA_LR); R.l1 = *(const u32x4*)(prow + C_GLA_LR + 8); }
    if (MODE == 1) { R.q0 = *(const u32x4*)(prow + CQ + h * 128 + k0); R.q1 = *(const u32x4*)(prow + CQ + h * 128 + k0 + 8); R.k0 = *(const u32x4*)(prow + CK + h * 128 + k0); R.k1 = *(const u32x4*)(prow + CK + h * 128 + k0 + 8); }
    if (MODE == 2) { const int i0 = sub * 8; R.q0 = *(const u32x4*)(prow + CQ + h * 128 + i0); R.q1 = *(const u32x4*)(prow + CQ + h * 128 + 64 + i0); R.k0 = *(const u32x4*)(prow + CK + h * 128 + i0); R.k1 = *(const u32x4*)(prow + CK + h * 128 + 64 + i0); }
    R.v0 = *(const u32x4*)(prow + CV + h * 128 + sub * 16); R.v1 = *(const u32x4*)(prow + CV + h * 128 + sub * 16 + 8);
}
template <int MODE>
__device__ __forceinline__ void stepA_lin(const Params& p, int l, int cgi, int h, LAS unsigned char* lds, const LinRegs& R) {
    constexpr int K = (MODE == 0) ? 64 : 128, KPT = K / 8;
    int tid = threadIdx.x; asm volatile("" : "+v"(tid));
    const ChunkInfo ci = chunk_info(cgi); const int idx = cgi * 4 + h, t = tid >> 3, sub = tid & 7;
    bf16_t* proj = (bf16_t*)(p.ws + OFF_PROJ);
    LAS bf16_t* QT = (LAS bf16_t*)(lds + LA_QT); LAS bf16_t* KT = (LAS bf16_t*)(lds + LA_KT); LAS bf16_t* KH = (LAS bf16_t*)(lds + LA_KH);
    LAS bf16_t* VT = (LAS bf16_t*)(lds + LA_VT); LAS bf16_t* ATT = (LAS bf16_t*)(lds + LA_ATT); LAS float* BB = (LAS float*)(lds + LA_BB);
    bf16_t* prow = proj + (size_t)(ci.row0 + t) * NPROJ;
    constexpr int CQ = (MODE == 0) ? C_GLA_Q : (MODE == 1 ? C_HG_Q : C_RET_Q), CK = (MODE == 0) ? C_GLA_K : (MODE == 1 ? C_HG_F : C_RET_K),
                  CV = (MODE == 0) ? C_GLA_V : (MODE == 1 ? C_HG_I : C_RET_V);
    bf16_t* ST = (bf16_t*)(p.ws + (MODE == 0 ? OFF_ST_GLA : (MODE == 1 ? OFF_ST_HG : OFF_ST_RET))) + (size_t)idx * 128 * K;
    const int k0 = sub * KPT;
    const u32x4 rq0 = R.q0, rq1 = R.q1, rk0 = R.k0, rk1 = R.k1, rv0 = R.v0, rv1 = R.v1;
    float lbv[KPT];
    if (MODE == 1) {
#pragma unroll
        for (int j = 0; j < KPT; ++j) { if (l == 0) lbv[j] = 0.f; else { const float z0 = p.in[I_LB][h * 128 + k0 + j], z1 = p.in[I_LB][512 + h * 128 + k0 + j]; lbv[j] = sigm(z1 - z0); } }
    }
    if (MODE == 0) {
        const u32x4 l0 = R.l0, l1 = R.l1;
        float lr[16]; unpack8(l0, lr); unpack8(l1, lr + 8);
        const float* wgk = p.in[I_WGK] + (size_t)l * 16 * 256 + h * 64 + k0; const float* bgk = p.in[I_BGK] + l * 256 + h * 64 + k0;
        float gk[8];
#pragma unroll
        for (int j = 0; j < 8; ++j) gk[j] = bgk[j];
#pragma unroll
        for (int r = 0; r < 16; ++r) { const float4 w0 = *(const float4*)(wgk + r * 256), w1 = *(const float4*)(wgk + r * 256 + 4);
            gk[0] += lr[r] * w0.x; gk[1] += lr[r] * w0.y; gk[2] += lr[r] * w0.z; gk[3] += lr[r] * w0.w; gk[4] += lr[r] * w1.x; gk[5] += lr[r] * w1.y; gk[6] += lr[r] * w1.z; gk[7] += lr[r] * w1.w; }
#pragma unroll
        for (int j = 0; j < 8; ++j) BB[t * LDBB + k0 + j] = logsig(gk[j]) * (1.f / 16.f);
    } else if (MODE == 1) {
        float z[16]; unpack8(rk0, z); unpack8(rk1, z + 8);
#pragma unroll
        for (int j = 0; j < 16; ++j) { const float f = lbv[j] + (1.f - lbv[j]) * sigm(z[j]); BB[t * LDBB + k0 + j] = __logf(f); }
    }
    float lg2 = 0.f;
    if (MODE == 2) lg2 = __log2f(1.f - exp2f(-5.f - (float)h));
    if (MODE != 2) {
        lds_barrier();
        {
            LAS float* GT = (LAS float*)(lds + LA_ATT); const int kk_ = tid & (K - 1), g_ = tid / K; float pv[16];
            if (tid < 4 * K) { float run = 0.f;
#pragma unroll
                for (int i = 0; i < 16; ++i) { run += BB[(g_ * 16 + i) * LDBB + kk_]; pv[i] = run; }
                GT[g_ * K + kk_] = run; }
            lds_barrier();
            if (tid < 4 * K) { float off = 0.f;
#pragma unroll
                for (int g2 = 0; g2 < 3; ++g2) off += (g2 < g_) ? GT[g2 * K + kk_] : 0.f;
#pragma unroll
                for (int i = 0; i < 16; ++i) BB[(g_ * 16 + i) * LDBB + kk_] = pv[i] + off; }
        }
        lds_barrier();
    }
    {
        float q[KPT], kk[KPT];
        if (MODE == 0) {
            unpack8(rq0, q); unpack8(rk0, kk);
#pragma unroll
            for (int j = 0; j < 8; ++j) q[j] *= 0.125f;
        } else if (MODE == 1) {
            unpack8(rq0, q); unpack8(rq1, q + 8); unpack8(rk0, kk); unpack8(rk1, kk + 8);
#pragma unroll
            for (int j = 0; j < 16; ++j) { q[j] = silu(q[j]); const float f = lbv[j] + (1.f - lbv[j]) * sigm(kk[j]); kk[j] = 1.f - f; }
        }
        if (MODE != 2) {
            float qt[KPT], kt[KPT], qx[KPT];
#pragma unroll
            for (int j = 0; j < KPT; ++j) { const float b = BB[t * LDBB + k0 + j], bm = BB[31 * LDBB + k0 + j], be = BB[63 * LDBB + k0 + j];
                qt[j] = q[j] * expc(b - bm); kt[j] = kk[j] * expc(bm - b); qx[j] = q[j] * __expf(b);
                KH[(k0 + j) * LDT + t] = f2bf(kk[j] * __expf(be - b));
                if (t == 63) ((float*)(p.ws + (MODE == 0 ? OFF_DEC_GLA : OFF_DEC_HG)))[(size_t)idx * K + k0 + j] = __expf(be); }
#pragma unroll
            for (int j = 0; j < KPT; j += 8) { *(LAS u32x4*)(QT + t * LDQ + k0 + j) = pack8(qt + j); *(LAS u32x4*)(KT + t * LDQ + k0 + j) = pack8(kt + j);
                *(u32x4*)(prow + CQ + h * K + k0 + j) = pack8(qx + j); }
        } else {
            const int i0 = sub * 8; const float pos = ci.pos0 + (float)t;
            float q1[8], q2[8], k1[8], k2[8];
            unpack8(rq0, q1); unpack8(rq1, q2); unpack8(rk0, k1); unpack8(rk1, k2);
            const float gq = exp2f(lg2 * (float)(t + 1)), gk_ = exp2f(lg2 * (float)(63 - t));
            float qa[8], qb[8], ka[8], kb[8], xa[8], xb[8];
#pragma unroll
            for (int j = 0; j < 8; ++j) {
                const float inv = exp2f(-(float)(i0 + j) * (13.287712379549449f / 64.f));
                const float ang = pos * inv;
                const float nrev = rintf(ang * 0.15915494309189535f);
                float rr = fmaf(-nrev, 6.2831854820251465f, ang); rr = fmaf(-nrev, -1.7484555e-7f, rr);
                const float cs = __cosf(rr), sn = __sinf(rr);
                qa[j] = q1[j] * cs - q2[j] * sn; qb[j] = q1[j] * sn + q2[j] * cs;
                const float ka_ = (k1[j] * cs - k2[j] * sn) * 0.08838834764831845f, kb_ = (k1[j] * sn + k2[j] * cs) * 0.08838834764831845f;
                ka[j] = ka_; kb[j] = kb_;
                KH[(i0 + j) * LDT + t] = f2bf(ka_ * gk_); KH[(64 + i0 + j) * LDT + t] = f2bf(kb_ * gk_);
                xa[j] = qa[j] * gq; xb[j] = qb[j] * gq;
            }
            *(LAS u32x4*)(QT + t * LDQ + i0) = pack8(qa); *(LAS u32x4*)(QT + t * LDQ + 64 + i0) = pack8(qb);
            *(LAS u32x4*)(KT + t * LDQ + i0) = pack8(ka); *(LAS u32x4*)(KT + t * LDQ + 64 + i0) = pack8(kb);
            *(u32x4*)(prow + CQ + h * 128 + i0) = pack8(xa); *(u32x4*)(prow + CQ + h * 128 + 64 + i0) = pack8(xb);
        }
        float v[16];
        unpack8(rv0, v); unpack8(rv1, v + 8);
#pragma unroll
        for (int j = 0; j < 16; ++j) VT[(sub * 16 + j) * LDT + t] = f2bf(v[j]);
    }
    lds_barrier();
    lds_mm(QT, LDQ, KT, LDQ, 2, 2, K / 32, [&](int r, int c, f32x4 a) {
        float o[4];
#pragma unroll
        for (int j = 0; j < 4; ++j) { float x = a[j]; if (MODE == 2) x *= exp2f(lg2 * (float)(r - c - j)); o[j] = (c + j <= r) ? x : 0.f; }
        u32x2 w; w[0] = cvt_pk_bf16(o[0], o[1]); w[1] = cvt_pk_bf16(o[2], o[3]); *(LAS u32x2*)(ATT + r * LDT + c) = w; });
    {
        const float* sin_ = p.in[MODE == 0 ? I_SGLA : (MODE == 1 ? I_SHG : I_SRET)] + ((size_t)(l * 32 + ci.b) * 4 + h) * K * 128;
        float* sout = p.out + (MODE == 0 ? O_SGLA : (MODE == 1 ? O_SHG : O_SRET)) + ((size_t)(l * 32 + ci.b) * 4 + h) * K * 128;
        const float dret = exp2f(lg2 * 64.f);
        lds_mm(VT, LDT, KH, LDT, 4, K / 32, 2, [&](int r, int c, f32x4 a) {
            u32x2 w;
            if (ci.sample) {
                float s0[4];
#pragma unroll
                for (int j = 0; j < 4; ++j) { s0[j] = sin_[(size_t)(c + j) * 128 + r]; const float d = (MODE == 2) ? dret : __expf(BB[63 * LDBB + c + j]); sout[(size_t)(c + j) * 128 + r] = d * s0[j] + a[j]; }
                w[0] = cvt_pk_bf16(s0[0], s0[1]); w[1] = cvt_pk_bf16(s0[2], s0[3]);
            } else { w[0] = cvt_pk_bf16(a[0], a[1]); w[1] = cvt_pk_bf16(a[2], a[3]); }
            *(u32x2*)(ST + (size_t)r * K + c) = w; });
    }
    lds_barrier();
    lds_mm(ATT, LDT, VT, LDT, 2, 4, 2, [&](int r, int c, f32x4 a) {
        u32x2 w; w[0] = cvt_pk_bf16(a[0], a[1]); w[1] = cvt_pk_bf16(a[2], a[3]);
        *(u32x2*)(proj + (size_t)(ci.row0 + r) * NPROJ + CV + h * 128 + c) = w; });
    lds_barrier();
}

constexpr int LG_Q = 0, LG_K = 17408, LG_KT = 34816, LG_VT = 53248, LG_WT = 71680, LG_ATT = 90112, LG_MM = 99328, LG_SC = 116736;
constexpr int LDMM = 68;
__device__ __forceinline__ void stepA_gdn(const Params& p, int l, int cgi, int h, LAS unsigned char* lds) {
    int tid = threadIdx.x; asm volatile("" : "+v"(tid));
    const ChunkInfo ci = chunk_info(cgi); const int idx = cgi * 4 + h, t = tid >> 3, sub = tid & 7;
    const bf16_t* proj = (const bf16_t*)(p.ws + OFF_PROJ);
    LAS bf16_t* Q = (LAS bf16_t*)(lds + LG_Q); LAS bf16_t* KK = (LAS bf16_t*)(lds + LG_K); LAS bf16_t* KTr = (LAS bf16_t*)(lds + LG_KT);
    LAS bf16_t* VT = (LAS bf16_t*)(lds + LG_VT); LAS bf16_t* WT = (LAS bf16_t*)(lds + LG_WT); LAS bf16_t* ATT = (LAS bf16_t*)(lds + LG_ATT);
    LAS float* MM = (LAS float*)(lds + LG_MM); LAS float* SB = (LAS float*)(lds + LG_SC);
    const float* cw = p.in[I_GCW] + (size_t)l * 4 * 1536;
    const float* cache = p.in[I_CGDN] + (size_t)(l * 32 + ci.b) * 3 * 1536;
    float* cout = p.out + (ci.sample ? O_SGC + (size_t)(l * 32 + ci.b) * 3 * 1536 : O_PGC + (size_t)(l * 2 + ci.b) * 3 * 1536);
#pragma unroll
    for (int part = 0; part < 3; ++part) {
        const int ch0 = part * 512 + h * 128 + sub * 16;
        float acc[16];
#pragma unroll
        for (int c = 0; c < 16; ++c) acc[c] = 0.f;
#pragma unroll
        for (int j = 0; j < 4; ++j) {
            const int tr = t + j - 3; float x[16];
            if (tr >= 0 || !ci.first) { const bf16_t* sp = proj + (size_t)(ci.row0 + tr) * NPROJ + C_GDN_QKV + ch0; unpack8(*(const u32x4*)sp, x); unpack8(*(const u32x4*)(sp + 8), x + 8); }
            else if (ci.sample) { const float* sp = cache + (size_t)(t + j) * 1536 + ch0;
#pragma unroll
                for (int c = 0; c < 16; c += 4) { const float4 f = *(const float4*)(sp + c); x[c] = f.x; x[c + 1] = f.y; x[c + 2] = f.z; x[c + 3] = f.w; } }
            else {
#pragma unroll
                for (int c = 0; c < 16; ++c) x[c] = 0.f; }
            const float* wp = cw + j * 1536 + ch0;
#pragma unroll
            for (int c = 0; c < 16; c += 4) { const float4 w = *(const float4*)(wp + c); acc[c] += w.x * x[c]; acc[c + 1] += w.y * x[c + 1]; acc[c + 2] += w.z * x[c + 2]; acc[c + 3] += w.w * x[c + 3]; }
            if (j == 3 && ci.last && t >= 61) {
                float* op = cout + (size_t)(t - 61) * 1536 + ch0;
#pragma unroll
                for (int c = 0; c < 16; c += 4) *(float4*)(op + c) = make_float4(x[c], x[c + 1], x[c + 2], x[c + 3]); }
        }
        float ss = 0.f;
#pragma unroll
        for (int c = 0; c < 16; ++c) { acc[c] = silu(acc[c]); ss += acc[c] * acc[c]; }
        if (part < 2) {
            ss += __shfl_xor(ss, 1); ss += __shfl_xor(ss, 2); ss += __shfl_xor(ss, 4);
            const float rn = rsqrtf(ss + 1e-6f) * (part == 0 ? 0.08838834764831845f : 1.f);
#pragma unroll
            for (int c = 0; c < 16; ++c) acc[c] *= rn;
            LAS bf16_t* dst = (part == 0) ? Q : KK;
            *(LAS u32x4*)(dst + t * LDQ + sub * 16) = pack8(acc); *(LAS u32x4*)(dst + t * LDQ + sub * 16 + 8) = pack8(acc + 8);
            if (part == 1) {
#pragma unroll
                for (int c = 0; c < 16; ++c) KTr[(sub * 16 + c) * LDT + t] = f2bf(acc[c]); }
        } else {
#pragma unroll
            for (int c = 0; c < 16; ++c) VT[(sub * 16 + c) * LDT + t] = f2bf(acc[c]);
        }
    }
    if (tid < 64) {
        const bf16_t* pr = proj + (size_t)(ci.row0 + tid) * NPROJ;
        const float beta = sigm(bf2f(pr[C_GDN_B + h]));
        float g = -__expf(p.in[I_ALOG][l * 4 + h]) * softplus(bf2f(pr[C_GDN_A + h]) + p.in[I_DTB][l * 4 + h]);
#pragma unroll
        for (int o = 1; o < 64; o <<= 1) { const float n = __shfl_up(g, o); if (tid >= o) g += n; }
        SB[tid] = g; SB[64 + tid] = beta; SB[128 + tid] = beta * __expf(g);
    }
    lds_barrier();
    lds_mm(KK, LDQ, KK, LDQ, 2, 2, 4, [&](int r, int c, f32x4 a) {
        const float br = SB[r], be = SB[64 + r];
        f32x4 o;
#pragma unroll
        for (int j = 0; j < 4; ++j) o[j] = (c + j < r) ? be * a[j] * __expf(br - SB[c + j]) : 0.f;
        *(LAS f32x4*)(MM + r * LDMM + c) = o; });
    lds_mm(Q, LDQ, KK, LDQ, 2, 2, 4, [&](int r, int c, f32x4 a) {
        const float br = SB[r]; float o[4];
#pragma unroll
        for (int j = 0; j < 4; ++j) o[j] = (c + j <= r) ? a[j] * __expf(br - SB[c + j]) : 0.f;
        u32x2 w; w[0] = cvt_pk_bf16(o[0], o[1]); w[1] = cvt_pk_bf16(o[2], o[3]); *(LAS u32x2*)(ATT + r * LDT + c) = w; });
    lds_barrier();
    if (tid < 256) {
        const bool isk = tid < 128;
        LAS bf16_t* rowp = isk ? (KTr + tid * LDT) : (VT + (tid - 128) * LDT);
        LAS bf16_t* dstp = isk ? (WT + tid * LDT) : rowp;
        const LAS float* fac = isk ? (SB + 128) : (SB + 64);
#pragma unroll 1
        for (int b0 = 0; b0 < 64; b0 += 16) {
            float s[16];
            { float x[8]; unpack8(*(const LAS u32x4*)(rowp + b0), x);
#pragma unroll
              for (int j = 0; j < 8; ++j) s[j] = x[j] * fac[b0 + j];
              unpack8(*(const LAS u32x4*)(rowp + b0 + 8), x);
#pragma unroll
              for (int j = 0; j < 8; ++j) s[8 + j] = x[j] * fac[b0 + 8 + j]; }
#pragma unroll 1
            for (int jc = 0; jc < b0; jc += 8) {
                float w8[8]; unpack8(*(const LAS u32x4*)(dstp + jc), w8);
#pragma unroll
                for (int i = 0; i < 16; ++i) {
                    const f32x4 m0 = *(const LAS f32x4*)(MM + (b0 + i) * LDMM + jc), m1 = *(const LAS f32x4*)(MM + (b0 + i) * LDMM + jc + 4);
                    s[i] -= m0[0] * w8[0] + m0[1] * w8[1] + m0[2] * w8[2] + m0[3] * w8[3] + m1[0] * w8[4] + m1[1] * w8[5] + m1[2] * w8[6] + m1[3] * w8[7];
                }
            }
#pragma unroll
            for (int i = 1; i < 16; ++i) {
#pragma unroll
                for (int j = 0; j < i; ++j) s[i] -= MM[(b0 + i) * LDMM + b0 + j] * s[j];
            }
            *(LAS u32x4*)(dstp + b0) = pack8(s); *(LAS u32x4*)(dstp + b0 + 8) = pack8(s + 8);
        }
    }
    lds_barrier();
    {
        const int i = tid >> 2, s0 = (tid & 3) * 16; const float bend = SB[63];
        float x[16]; unpack8(*(const LAS u32x4*)(KTr + i * LDT + s0), x); unpack8(*(const LAS u32x4*)(KTr + i * LDT + s0 + 8), x + 8);
#pragma unroll
        for (int j = 0; j < 16; ++j) x[j] *= __expf(bend - SB[s0 + j]);
        *(LAS u32x4*)(KTr + i * LDT + s0) = pack8(x); *(LAS u32x4*)(KTr + i * LDT + s0 + 8) = pack8(x + 8);
    }
    bf16_t* GQX = (bf16_t*)(p.ws + OFF_GQX) + (size_t)idx * 64 * 128; bf16_t* GO0 = (bf16_t*)(p.ws + OFF_GO0) + (size_t)idx * 64 * 128;
    lds_mm(ATT, LDT, WT, LDT, 2, 4, 2, [&](int r, int c, f32x4 a) {
        const float eb = __expf(SB[r]); float o[4];
#pragma unroll
        for (int j = 0; j < 4; ++j) o[j] = bf2f(Q[r * LDQ + c + j]) * eb - a[j];
        u32x2 w; w[0] = cvt_pk_bf16(o[0], o[1]); w[1] = cvt_pk_bf16(o[2], o[3]); *(u32x2*)(GQX + r * 128 + c) = w; });
    lds_mm(ATT, LDT, VT, LDT, 2, 4, 2, [&](int r, int c, f32x4 a) {
        u32x2 w; w[0] = cvt_pk_bf16(a[0], a[1]); w[1] = cvt_pk_bf16(a[2], a[3]); *(u32x2*)(GO0 + r * 128 + c) = w; });
    lds_barrier();
    bf16_t* AG = (bf16_t*)(p.ws + OFF_A_GDN) + (size_t)idx * 128 * 128; bf16_t* BG = (bf16_t*)(p.ws + OFF_ST_GDN) + (size_t)idx * 128 * 128;
    const float ebe = __expf(SB[63]);
    lds_mm(KTr, LDT, WT, LDT, 4, 4, 2, [&](int r, int c, f32x4 a) {
        float o[4];
#pragma unroll
        for (int j = 0; j < 4; ++j) o[j] = ((r == c + j) ? ebe : 0.f) - a[j];
        u32x2 w; w[0] = cvt_pk_bf16(o[0], o[1]); w[1] = cvt_pk_bf16(o[2], o[3]); *(u32x2*)(AG + r * 128 + c) = w; });
    lds_mm(VT, LDT, KTr, LDT, 4, 4, 2, [&](int r, int c, f32x4 a) {
        u32x2 w; w[0] = cvt_pk_bf16(a[0], a[1]); w[1] = cvt_pk_bf16(a[2], a[3]); *(u32x2*)(BG + r * 128 + c) = w; });
    lds_barrier();
}

__device__ __forceinline__ void phase_stepA(const Params& p, int l, LAS unsigned char* lds) {
    const int G = gridDim.x; int it = blockIdx.x;
    for (; it < NITEM; it += G) stepA_gdn(p, l, it >> 2, it & 3, lds);
#define LIN_LOOP(MODE, BASE) { LinRegs R{}, N{}; const int tid_ = threadIdx.x; \
        if (it < (BASE) + NITEM) { const int j = it - (BASE); lin_load<MODE>(p, j >> 2, j & 3, tid_, R); } \
        for (; it < (BASE) + NITEM; it += G) { const int j = it - (BASE), jn = j + G; N = R; \
            if (it + G < (BASE) + NITEM) lin_load<MODE>(p, jn >> 2, jn & 3, tid_, N);        \
            stepA_lin<MODE>(p, l, j >> 2, j & 3, lds, R); R = N; } }
    LIN_LOOP(1, NITEM)
    LIN_LOOP(2, 2 * NITEM)
    LIN_LOOP(0, 3 * NITEM)
#undef LIN_LOOP
}

__device__ __forceinline__ void gdn_chain(const Params& p, int cg0, int nsteps, int h, int vs, const float* sin_, float* sout, LAS unsigned char* lds) {
    const int tid = threadIdx.x, wid = tid >> 6, lane = tid & 63, fr = lane & 15, fq = lane >> 4, i0 = wid * 16;
    constexpr int NS = 33, SLOT = 16 * LDQ;
    LAS bf16_t* XS = (LAS bf16_t*)lds;
    const bf16_t* AG = (const bf16_t*)(p.ws + OFF_A_GDN); bf16_t* SG = (bf16_t*)(p.ws + OFF_ST_GDN);
    constexpr int PD = 8, UNR = 32;
    bf16x8 af[PD][4]; u32x2 bt[PD];
#pragma unroll
    for (int u = 0; u < PD; ++u) {
        if (u < nsteps) { const size_t idx = (size_t)(cg0 + u) * 4 + h;
#pragma unroll
            for (int ks = 0; ks < 4; ++ks) af[u][ks] = *(const bf16x8*)(AG + (idx * 128 + i0 + fr) * 128 + ks * 32 + fq * 8);
            bt[u] = *(const u32x2*)(SG + (idx * 128 + vs * 16 + fr) * 128 + i0 + fq * 4); }
    }
    f32x4 cur = {0.f, 0.f, 0.f, 0.f};
    {
        const int k = tid >> 2, v4 = (tid & 3) * 4;
        float4 s = make_float4(0.f, 0.f, 0.f, 0.f);
        if (sin_) s = *(const float4*)(sin_ + (size_t)k * 128 + vs * 16 + v4);
        if (sin_) {
#pragma unroll
            for (int j = 0; j < 4; ++j) cur[j] = sin_[(size_t)(i0 + fq * 4 + j) * 128 + vs * 16 + fr]; }
        XS[(v4 + 0) * LDQ + k] = f2bf(s.x); XS[(v4 + 1) * LDQ + k] = f2bf(s.y); XS[(v4 + 2) * LDQ + k] = f2bf(s.z); XS[(v4 + 3) * LDQ + k] = f2bf(s.w);
    }
    lds_barrier();
    for (int c0 = 0; c0 < nsteps; c0 += UNR) {
        const int sb = c0 % NS;
#pragma unroll
        for (int uu = 0; uu < UNR; ++uu) {
            const int u = uu & (PD - 1), c = c0 + uu;
            if (c < nsteps) {
                int sr = sb + uu; sr = sr >= NS ? sr - NS : sr; int sw = sr + 1; sw = sw >= NS ? sw - NS : sw;
                f32x4 acc = {bflo(bt[u][0]), bfhi(bt[u][0]), bflo(bt[u][1]), bfhi(bt[u][1])};
                const LAS bf16_t* xs = XS + sr * SLOT + fr * LDQ + fq * 8;
                {
                    f32x4 acc2 = {0.f, 0.f, 0.f, 0.f};
                    const bf16x8 x0 = *(const LAS bf16x8*)(xs), x1 = *(const LAS bf16x8*)(xs + 32), x2 = *(const LAS bf16x8*)(xs + 64), x3 = *(const LAS bf16x8*)(xs + 96);
                    acc = __builtin_amdgcn_mfma_f32_16x16x32_bf16(af[u][0], x0, acc, 0, 0, 0); acc2 = __builtin_amdgcn_mfma_f32_16x16x32_bf16(af[u][1], x1, acc2, 0, 0, 0);
                    acc = __builtin_amdgcn_mfma_f32_16x16x32_bf16(af[u][2], x2, acc, 0, 0, 0); acc2 = __builtin_amdgcn_mfma_f32_16x16x32_bf16(af[u][3], x3, acc2, 0, 0, 0);
                    acc += acc2;
                }
                cur = acc;
                { u32x2 w; w[0] = cvt_pk_bf16(cur[0], cur[1]); w[1] = cvt_pk_bf16(cur[2], cur[3]); *(LAS u32x2*)(XS + sw * SLOT + fr * LDQ + i0 + fq * 4) = w; }
                if (c + PD < nsteps) { const size_t idn = (size_t)(cg0 + c + PD) * 4 + h;
#pragma unroll
                    for (int ks = 0; ks < 4; ++ks) af[u][ks] = *(const bf16x8*)(AG + (idn * 128 + i0 + fr) * 128 + ks * 32 + fq * 8);
                    bt[u] = *(const u32x2*)(SG + (idn * 128 + vs * 16 + fr) * 128 + i0 + fq * 4); }
                lds_barrier();
            }
        }
        const int nb = min(UNR, nsteps - c0), piece = tid & 255, prow = piece >> 4, pc8 = (piece & 15) * 8;
        for (int uu = tid >> 8; uu < nb; uu += 2) {
            int sr = sb + uu; sr = sr >= NS ? sr - NS : sr;
            const u32x4 v = *(const LAS u32x4*)(XS + sr * SLOT + prow * LDQ + pc8);
            *(u32x4*)(SG + (((size_t)(cg0 + c0 + uu) * 4 + h) * 128 + vs * 16 + prow) * 128 + pc8) = v;
        }
        lds_barrier();
    }
#pragma unroll
    for (int j = 0; j < 4; ++j) sout[(size_t)(i0 + fq * 4 + j) * 128 + vs * 16 + fr] = cur[j];
    lds_barrier();
}

template <int K, int HASD>
__device__ __forceinline__ void lin_chain(bf16_t* ST, const float* DEC, float dconst, int s, int h, int v, int kg, float* pout) {
    float S[8];
#pragma unroll
    for (int j = 0; j < 8; ++j) S[j] = 0.f;
    for (int c0 = 0; c0 < 128; c0 += 8) {
        u32x4 U[8]; float4 D0[8], D1[8];
#pragma unroll
        for (int u = 0; u < 8; ++u) { const size_t idx = (size_t)(s * 128 + c0 + u) * 4 + h;
            U[u] = *(const u32x4*)(ST + (idx * 128 + v) * K + kg * 8);
            if (HASD) { D0[u] = *(const float4*)(DEC + idx * K + kg * 8); D1[u] = *(const float4*)(DEC + idx * K + kg * 8 + 4); } }
#pragma unroll
        for (int u = 0; u < 8; ++u) { const size_t idx = (size_t)(s * 128 + c0 + u) * 4 + h;
            *(u32x4*)(ST + (idx * 128 + v) * K + kg * 8) = pack8(S);
            float uf[8]; unpack8(U[u], uf);
            if (HASD) { S[0] = D0[u].x * S[0] + uf[0]; S[1] = D0[u].y * S[1] + uf[1]; S[2] = D0[u].z * S[2] + uf[2]; S[3] = D0[u].w * S[3] + uf[3];
                        S[4] = D1[u].x * S[4] + uf[4]; S[5] = D1[u].y * S[5] + uf[5]; S[6] = D1[u].z * S[6] + uf[6]; S[7] = D1[u].w * S[7] + uf[7]; }
            else {
#pragma unroll
                for (int j = 0; j < 8; ++j) S[j] = dconst * S[j] + uf[j]; } }
    }
#pragma unroll
    for (int j = 0; j < 8; ++j) pout[(size_t)(kg * 8 + j) * 128 + v] = S[j];
}

__device__ __forceinline__ void late_weights(const Params& p, int l, LAS unsigned char* lds) {
    unsigned char* ws = p.ws; LAS unsigned* tl = (LAS unsigned*)lds; int rot = 0; const int first = 64, cnt = (int)gridDim.x - 64;
    lds_barrier();
    conv_job(p.in[I_WOUT] + (size_t)l * DM * DM, DM, DM, 0, DM, (bf16_t*)(ws + OFF_WOUT), DM, 0, tl, rot, first, cnt);
    conv_job<2>(p.in[I_WFI] + (size_t)l * DM * NFI, NFI, DM, 0, NFI, (bf16_t*)(ws + OFF_WFI), DM, 0, tl, rot, first, cnt);
    conv_job(p.in[I_WFO] + (size_t)l * DFF * DM, DM, DFF, 0, DM, (bf16_t*)(ws + OFF_WFO), DFF, 0, tl, rot, first, cnt);
}
__device__ __forceinline__ void phase_scan(const Params& p, int l, LAS unsigned char* lds) {
    const int bid = blockIdx.x, G = gridDim.x;
    if (bid < 64) {
        const int chain = bid >> 3, vs = bid & 7, s = chain >> 2, h = chain & 3;
        gdn_chain(p, s * 128, 128, h, vs, nullptr, p.out + O_PGDN + ((size_t)(l * 2 + s) * 4 + h) * 128 * 128, lds);
        return;
    }
    for (int j = bid - 64; j < 1024; j += G - 64) {
        const int b = j >> 5, h = (j >> 3) & 3, vs = j & 7;
        gdn_chain(p, 256 + b, 1, h, vs, p.in[I_SGDN] + ((size_t)(l * 32 + b) * 4 + h) * 128 * 128, p.out + O_SGDN + ((size_t)(l * 32 + b) * 4 + h) * 128 * 128, lds);
    }
    for (int e = (bid - 64) * 512 + (int)threadIdx.x; e < 40960; e += (G - 64) * 512) {
        const int sh = e / 5120, r = e - sh * 5120, s = sh >> 2, h = sh & 3;
        if (r < 1024) lin_chain<64, 1>((bf16_t*)(p.ws + OFF_ST_GLA), (const float*)(p.ws + OFF_DEC_GLA), 0.f, s, h, r >> 3, r & 7, p.out + O_PGLA + ((size_t)(l * 2 + s) * 4 + h) * 64 * 128);
        else if (r < 3072) { const int q = r - 1024; lin_chain<128, 1>((bf16_t*)(p.ws + OFF_ST_HG), (const float*)(p.ws + OFF_DEC_HG), 0.f, s, h, q >> 4, q & 15, p.out + O_PHG + ((size_t)(l * 2 + s) * 4 + h) * 128 * 128); }
        else { const int q = r - 3072; const float d = exp2f(64.f * __log2f(1.f - exp2f(-5.f - (float)h)));
            lin_chain<128, 0>((bf16_t*)(p.ws + OFF_ST_RET), nullptr, d, s, h, q >> 4, q & 15, p.out + O_PRET + ((size_t)(l * 2 + s) * 4 + h) * 128 * 128); }
    }
    late_weights(p, l, lds);
}

constexpr int LC_QX = 0, LC_SX = 17408, LC_O = 52224;
struct StepCItem { const bf16_t* qsrc; const bf16_t* osrc; const bf16_t* st; const bf16_t* gp; const float* ng; const float* nb; bf16_t* op; int ldq, ldo, K, br; };
struct StepCRegs { u32x4 s[4]; u32x4 q[2]; u32x2 o[4]; u32x4 g[2]; };
__device__ __forceinline__ StepCItem stepC_item(const Params& p, int l, int it, int t, int sub) {
    StepCItem I; const bf16_t* proj = (const bf16_t*)(p.ws + OFF_PROJ);
    const int br = it & 3, j = it >> 2, cgi = j >> 2, h = j & 3, idx = j, row0 = cgi * 64;
    int gcol; I.br = br; I.K = (br == 0) ? 64 : 128; I.nb = nullptr;
    if (br == 0) { I.qsrc = proj + (size_t)row0 * NPROJ + C_GLA_Q + h * 64; I.ldq = NPROJ; I.osrc = proj + (size_t)row0 * NPROJ + C_GLA_V + h * 128; I.ldo = NPROJ;
        I.st = (const bf16_t*)(p.ws + OFF_ST_GLA) + (size_t)idx * 128 * 64; gcol = C_GLA_G; I.ng = p.in[I_GLANG] + l * 128; }
    else if (br == 1) { I.qsrc = proj + (size_t)row0 * NPROJ + C_HG_Q + h * 128; I.ldq = NPROJ; I.osrc = proj + (size_t)row0 * NPROJ + C_HG_I + h * 128; I.ldo = NPROJ;
        I.st = (const bf16_t*)(p.ws + OFF_ST_HG) + (size_t)idx * 128 * 128; gcol = C_HG_G; I.ng = p.in[I_HGNG] + l * 128; }
    else if (br == 2) { I.qsrc = (const bf16_t*)(p.ws + OFF_GQX) + (size_t)idx * 64 * 128; I.ldq = 128; I.osrc = (const bf16_t*)(p.ws + OFF_GO0) + (size_t)idx * 64 * 128; I.ldo = 128;
        I.st = (const bf16_t*)(p.ws + OFF_ST_GDN) + (size_t)idx * 128 * 128; gcol = C_GDN_Z; I.ng = p.in[I_GDNNG] + l * 128; }
    else { I.qsrc = proj + (size_t)row0 * NPROJ + C_RET_Q + h * 128; I.ldq = NPROJ; I.osrc = proj + (size_t)row0 * NPROJ + C_RET_V + h * 128; I.ldo = NPROJ;
        I.st = (const bf16_t*)(p.ws + OFF_ST_RET) + (size_t)idx * 128 * 128; gcol = C_RET_G; I.ng = p.in[I_RETNG] + l * 128; I.nb = p.in[I_RETNB] + l * 128; }
    I.gp = proj + (size_t)(row0 + t) * NPROJ + gcol + h * 128 + sub * 16;
    I.op = (bf16_t*)(p.ws + OFF_OCAT) + (size_t)(row0 + t) * DM + br * 512 + h * 128 + sub * 16;
    return I;
}
__device__ __forceinline__ void stepC_load(const StepCItem& I, StepCRegs& R, int tid, int t, int sub, int r, int c0) {
    const int kpr = I.K / 8, npc = 128 * kpr;
#pragma unroll
    for (int i = 0; i < 4; ++i) { const int pc = tid + i * 512; if (pc < npc) { const int v = pc / kpr, kq = pc - v * kpr; R.s[i] = *(const u32x4*)(I.st + (size_t)v * I.K + kq * 8); } }
    if (sub * 16 < I.K) { const bf16_t* sp = I.qsrc + (size_t)t * I.ldq + sub * 16; R.q[0] = *(const u32x4*)sp; R.q[1] = *(const u32x4*)(sp + 8); }
    R.o[0] = *(const u32x2*)(I.osrc + (size_t)r * I.ldo + c0); R.o[1] = *(const u32x2*)(I.osrc + (size_t)r * I.ldo + c0 + 16);
    R.o[2] = *(const u32x2*)(I.osrc + (size_t)(r + 16) * I.ldo + c0); R.o[3] = *(const u32x2*)(I.osrc + (size_t)(r + 16) * I.ldo + c0 + 16);
    R.g[0] = *(const u32x4*)I.gp; R.g[1] = *(const u32x4*)(I.gp + 8);
}
__device__ __forceinline__ void phase_stepC(const Params& p, int l, LAS unsigned char* lds) {
    const int tid = threadIdx.x, t = tid >> 3, sub = tid & 7;
    LAS bf16_t* QX = (LAS bf16_t*)(lds + LC_QX); LAS bf16_t* SX = (LAS bf16_t*)(lds + LC_SX); LAS float* OB = (LAS float*)(lds + LC_O);
    const int wid = tid >> 6, lane = tid & 63, fr = lane & 15, fq = lane >> 4, r = (wid >> 2) * 32 + fr, c0 = (wid & 3) * 32 + fq * 4;
    int it = blockIdx.x;
    if (it >= 4 * NITEM) return;
    StepCItem I = stepC_item(p, l, it, t, sub); StepCRegs R;
    stepC_load(I, R, tid, t, sub, r, c0);
    for (; it < 4 * NITEM; it += gridDim.x) {
        { const int kpr = I.K / 8, npc = 128 * kpr;
#pragma unroll
          for (int i = 0; i < 4; ++i) { const int pc = tid + i * 512; if (pc < npc) { const int v = pc / kpr, kq = pc - v * kpr; *(LAS u32x4*)(SX + v * LDQ + kq * 8) = R.s[i]; } }
          if (sub * 16 < I.K) { *(LAS u32x4*)(QX + t * LDQ + sub * 16) = R.q[0]; *(LAS u32x4*)(QX + t * LDQ + sub * 16 + 8) = R.q[1]; } }
        const u32x2 o00 = R.o[0], o01 = R.o[1], o10 = R.o[2], o11 = R.o[3]; const u32x4 g0 = R.g[0], g1 = R.g[1];
        const StepCItem C = I;
        lds_barrier();
        const int itn = it + gridDim.x;
        if (itn < 4 * NITEM) { I = stepC_item(p, l, itn, t, sub); stepC_load(I, R, tid, t, sub, r, c0); }
        {
            f32x4 a00 = {0.f, 0.f, 0.f, 0.f}, a01 = a00, a10 = a00, a11 = a00;
            const LAS bf16_t* xp = QX + r * LDQ + fq * 8; const LAS bf16_t* yp = SX + ((wid & 3) * 32 + fr) * LDQ + fq * 8;
            for (int k = 0; k < C.K / 32; ++k) {
                const bf16x8 x0 = *(const LAS bf16x8*)(xp + k * 32), x1 = *(const LAS bf16x8*)(xp + 16 * LDQ + k * 32);
                const bf16x8 y0 = *(const LAS bf16x8*)(yp + k * 32), y1 = *(const LAS bf16x8*)(yp + 16 * LDQ + k * 32);
                a00 = __builtin_amdgcn_mfma_f32_16x16x32_bf16(y0, x0, a00, 0, 0, 0); a01 = __builtin_amdgcn_mfma_f32_16x16x32_bf16(y1, x0, a01, 0, 0, 0);
                a10 = __builtin_amdgcn_mfma_f32_16x16x32_bf16(y0, x1, a10, 0, 0, 0); a11 = __builtin_amdgcn_mfma_f32_16x16x32_bf16(y1, x1, a11, 0, 0, 0);
            }
            *(LAS f32x4*)(OB + r * LDBB + c0) = (f32x4){a00[0] + bflo(o00[0]), a00[1] + bfhi(o00[0]), a00[2] + bflo(o00[1]), a00[3] + bfhi(o00[1])};
            *(LAS f32x4*)(OB + r * LDBB + c0 + 16) = (f32x4){a01[0] + bflo(o01[0]), a01[1] + bfhi(o01[0]), a01[2] + bflo(o01[1]), a01[3] + bfhi(o01[1])};
            *(LAS f32x4*)(OB + (r + 16) * LDBB + c0) = (f32x4){a10[0] + bflo(o10[0]), a10[1] + bfhi(o10[0]), a10[2] + bflo(o10[1]), a10[3] + bfhi(o10[1])};
            *(LAS f32x4*)(OB + (r + 16) * LDBB + c0 + 16) = (f32x4){a11[0] + bflo(o11[0]), a11[1] + bfhi(o11[0]), a11[2] + bflo(o11[1]), a11[3] + bfhi(o11[1])};
        }
        lds_barrier();
        {
            float o[16]; float s1 = 0.f, s2 = 0.f;
#pragma unroll
            for (int c = 0; c < 16; c += 4) { const f32x4 v = *(const LAS f32x4*)(OB + t * LDBB + sub * 16 + c); o[c] = v[0]; o[c + 1] = v[1]; o[c + 2] = v[2]; o[c + 3] = v[3]; }
#pragma unroll
            for (int c = 0; c < 16; ++c) { s1 += o[c]; s2 += o[c] * o[c]; }
            s1 += __shfl_xor(s1, 1); s1 += __shfl_xor(s1, 2); s1 += __shfl_xor(s1, 4);
            s2 += __shfl_xor(s2, 1); s2 += __shfl_xor(s2, 2); s2 += __shfl_xor(s2, 4);
            float mu = 0.f, rs;
            if (C.br == 3) { mu = s1 * (1.f / 128.f); const float var = fmaxf(s2 * (1.f / 128.f) - mu * mu, 0.f); rs = rsqrtf(var + 1e-6f); }
            else rs = rsqrtf(s2 * (1.f / 128.f) + 1e-6f);
            float gt[16]; unpack8(g0, gt); unpack8(g1, gt + 8);
            float y[16];
#pragma unroll
            for (int c = 0; c < 16; ++c) { float v = (o[c] - mu) * rs * C.ng[sub * 16 + c]; if (C.br == 3) v += C.nb[sub * 16 + c]; y[c] = v * silu(gt[c]); }
            *(u32x4*)C.op = pack8(y); *(u32x4*)(C.op + 8) = pack8(y + 8);
        }
        lds_barrier();
    }
}

__device__ __forceinline__ void phase_ffn_fix(const Params& p, int l) {
    const bf16_t* halo = (const bf16_t*)(p.ws + OFF_HALO); bf16_t* act = (bf16_t*)(p.ws + OFF_ACT);
    const float* cw = p.in[I_FCW] + (size_t)l * 3 * DFF; const float* cb = p.in[I_FCB] + (size_t)l * DFF;
    const bool split = (gridDim.x == 256);
    for (int w = blockIdx.x * 512 + threadIdx.x; w < NCHUNK * 688; w += gridDim.x * 512) {
        const int cgi = w / 688, j0 = (w - cgi * 688) * 8;
        if (split && cgi >= pg8::FFN_SPLIT_PM0 * 4 && j0 >= pg8::FFN_SPLIT_PN * 128) continue;
        const ChunkInfo ci = chunk_info(cgi);
        float a0[8], a1[8], u0[8], u1[8], h1[8], h2[8], y0[8], y1[8];
        const bf16_t* hc = halo + (size_t)cgi * 8 * DFF + j0;
        unpack8(*(const u32x4*)hc, a0); unpack8(*(const u32x4*)(hc + DFF), u0); unpack8(*(const u32x4*)(hc + 2 * DFF), a1); unpack8(*(const u32x4*)(hc + 3 * DFF), u1);
        if (!ci.first) { const bf16_t* hp = halo + (size_t)(cgi - 1) * 8 * DFF + j0; unpack8(*(const u32x4*)(hp + 4 * DFF), h2); unpack8(*(const u32x4*)(hp + 6 * DFF), h1); }
        else if (ci.sample) { const float* cp = p.in[I_CFFN] + (size_t)(l * 32 + ci.b) * 2 * DFF + j0;
#pragma unroll
            for (int c = 0; c < 8; ++c) { h2[c] = cp[c]; h1[c] = cp[DFF + c]; } }
        else {
#pragma unroll
            for (int c = 0; c < 8; ++c) { h1[c] = 0.f; h2[c] = 0.f; } }
#pragma unroll
        for (int c = 0; c < 8; ++c) { const float k0 = cw[j0 + c], k1 = cw[DFF + j0 + c], k2 = cw[2 * DFF + j0 + c], b = cb[j0 + c];
            y0[c] = silu(k0 * h2[c] + k1 * h1[c] + k2 * a0[c] + b) * u0[c]; y1[c] = silu(k0 * h1[c] + k1 * a0[c] + k2 * a1[c] + b) * u1[c]; }
        *(u32x4*)(act + (size_t)ci.row0 * DFF + j0) = pack8(y0); *(u32x4*)(act + (size_t)(ci.row0 + 1) * DFF + j0) = pack8(y1);
        if (ci.last) { float* co = p.out + (ci.sample ? O_SFC + (size_t)(l * 32 + ci.b) * 2 * DFF : O_PFC + (size_t)(l * 2 + ci.b) * 2 * DFF) + j0;
            float e0[8], e1[8]; unpack8(*(const u32x4*)(hc + 4 * DFF), e0); unpack8(*(const u32x4*)(hc + 6 * DFF), e1);
            *(float4*)co = make_float4(e0[0], e0[1], e0[2], e0[3]); *(float4*)(co + 4) = make_float4(e0[4], e0[5], e0[6], e0[7]);
            *(float4*)(co + DFF) = make_float4(e1[0], e1[1], e1[2], e1[3]); *(float4*)(co + DFF + 4) = make_float4(e1[4], e1[5], e1[6], e1[7]); }
    }
    if (split) {
        const float* pf = (const float*)(p.ws + OFF_PARTF);
        constexpr int CH0 = pg8::FFN_SPLIT_PM0 * 4, JC0 = pg8::FFN_SPLIT_PN * 128;
        for (int w = blockIdx.x * 512 + threadIdx.x; w < (NCHUNK - CH0) * 4 * 128; w += gridDim.x * 512) {
            const int c = w & 127, qq = (w >> 7) & 3, cgi = CH0 + (w >> 9), j = JC0 + c;
            const ChunkInfo ci = chunk_info(cgi);
            const float k0 = cw[j], k1 = cw[DFF + j], k2 = cw[2 * DFF + j], bb = cb[j];
            auto gate_at = [&](int row) -> float {
                const float* q = pf + ((size_t)((row >> 8) - pg8::FFN_SPLIT_PM0) * 65536) + (size_t)(row & 255) * 256 + c;
                return q[0] + q[(size_t)24 * 65536] + q[(size_t)48 * 65536] + q[(size_t)72 * 65536]; };
            auto up_at = [&](int row) -> float {
                const float* q = pf + ((size_t)((row >> 8) - pg8::FFN_SPLIT_PM0) * 65536) + (size_t)(row & 255) * 256 + 128 + c;
                return q[0] + q[(size_t)24 * 65536] + q[(size_t)48 * 65536] + q[(size_t)72 * 65536]; };
            const int t0 = qq * 16, r0 = ci.row0 + t0;
            float h1, h2;
            if (t0 > 0 || (!ci.first && cgi > CH0)) { h1 = gate_at(r0 - 1); h2 = gate_at(r0 - 2); }
            else if (!ci.first) { const bf16_t* hp = halo + (size_t)(cgi - 1) * 8 * DFF + j; h2 = bf2f(hp[4 * DFF]); h1 = bf2f(hp[6 * DFF]); }
            else if (ci.sample) { const float* cp = p.in[I_CFFN] + (size_t)(l * 32 + ci.b) * 2 * DFF + j; h2 = cp[0]; h1 = cp[DFF]; }
            else { h1 = 0.f; h2 = 0.f; }
            float* co = p.out + (ci.sample ? O_SFC + (size_t)(l * 32 + ci.b) * 2 * DFF : O_PFC + (size_t)(l * 2 + ci.b) * 2 * DFF) + j;
#pragma unroll 4
            for (int t = 0; t < 16; ++t) {
                const int row = r0 + t; const float a = gate_at(row), uu = up_at(row);
                act[(size_t)row * DFF + j] = f2bf(silu(k0 * h2 + k1 * h1 + k2 * a + bb) * uu);
                if (ci.last && t0 + t >= 62) co[(size_t)(t0 + t - 62) * DFF] = a;
                h2 = h1; h1 = a;
            }
        }
    }
}

#define XB_TMO      128
#define XB_XCNT(j)  (256  + 64 * (j))
#define XB_XSUB(j)  (1280 + 64 * (j))
#define XB_XGEN(j)  (2304 + 64 * (j))
#define XB_TOP      3328
#define XB_TOPGEN   3392
#define XCD_BAR_WORDS 3456
#define XB_SPIN_CAP (1u << 23)
__device__ __forceinline__ unsigned xb_ld(unsigned* p)              { return __hip_atomic_load(p, __ATOMIC_RELAXED, __HIP_MEMORY_SCOPE_AGENT); }
__device__ __forceinline__ unsigned xb_add(unsigned* p, unsigned v) { return __hip_atomic_fetch_add(p, v, __ATOMIC_RELAXED, __HIP_MEMORY_SCOPE_AGENT); }
__device__ __forceinline__ unsigned xb_xcc_id() { return (unsigned)__builtin_amdgcn_s_getreg((3 << 11) | 20) & 0xFu; }
#define XB_SPIN(cond, bar) do { unsigned _sp = 0; while (cond) { __builtin_amdgcn_s_sleep(1); \
    if ((++_sp & 255u) == 0u) { if (xb_ld(&(bar)[XB_TMO])) break; if (_sp > XB_SPIN_CAP) { atomicAdd(&(bar)[XB_TMO], 1u); break; } } } } while (0)
struct XcdBarrier { unsigned* bar; unsigned x; volatile LAS unsigned* st; };
__device__ __forceinline__ XcdBarrier xcd_barrier_post(unsigned* bar, volatile LAS unsigned* st) {
    XcdBarrier b; b.bar = bar; b.x = xb_xcc_id(); b.st = st;
    if (threadIdx.x == 0) (void)xb_add(&bar[XB_XCNT(b.x)], 1u);
    return b;
}
__device__ __forceinline__ void xcd_barrier_complete(unsigned* bar, unsigned x, unsigned& nloc, unsigned& nx) {
    const unsigned G = gridDim.x * gridDim.y * gridDim.z;
    unsigned sum, cnt, mine, sp = 0u;
    for (;;) {
        sum = 0u; cnt = 0u; mine = 0u;
#pragma unroll
        for (unsigned j = 0; j < 16; ++j) { const unsigned c = xb_ld(&bar[XB_XCNT(j)]); sum += c; cnt += (c > 0u) ? 1u : 0u; mine = (j == x) ? c : mine; }
        if (sum == G) break;
        __builtin_amdgcn_s_sleep(1);
        if ((++sp & 255u) == 0u) { if (xb_ld(&bar[XB_TMO])) break; if (sp > XB_SPIN_CAP) { atomicAdd(&bar[XB_TMO], 1u); break; } }
    }
    nloc = mine > 0u ? mine : 1u; nx = cnt > 0u ? cnt : 1u;
}
__device__ __forceinline__ void xcd_barrier(const XcdBarrier& b) {
    asm volatile("s_waitcnt vmcnt(0)" ::: "memory");
    __syncthreads();
    if (threadIdx.x == 0) {
        unsigned* bar = b.bar;
        __builtin_amdgcn_s_waitcnt(0);
        unsigned nloc = b.st[0], nx = b.st[1];
        if (nloc == 0u) { xcd_barrier_complete(bar, b.x, nloc, nx); b.st[0] = nloc; b.st[1] = nx; }
        const unsigned old = xb_add(&bar[XB_XSUB(b.x)], 1u);
        const unsigned gen = old / nloc;
        if (old + 1u == (gen + 1u) * nloc) {
            __builtin_amdgcn_fence(__ATOMIC_RELEASE, "agent");
            asm volatile("s_waitcnt vmcnt(0)" ::: "memory");
            const unsigned og = xb_add(&bar[XB_TOP], 1u);
            const unsigned tg = og / nx;
            if (og + 1u == (tg + 1u) * nx) xb_add(&bar[XB_TOPGEN], 1u);
            else XB_SPIN(xb_ld(&bar[XB_TOPGEN]) == tg, bar);
            __builtin_amdgcn_fence(__ATOMIC_ACQUIRE, "agent");
            xb_add(&bar[XB_XGEN(b.x)], 1u);
            asm volatile("s_waitcnt vmcnt(0)" ::: "memory");
        } else {
            XB_SPIN(xb_ld(&bar[XB_XGEN(b.x)]) == gen, bar);
            __builtin_amdgcn_fence(__ATOMIC_ACQUIRE, "agent");
            asm volatile("s_waitcnt vmcnt(0)" ::: "memory");
        }
    }
    __syncthreads();
}

constexpr int PH_PER_LAYER = 12, N_PHASES = 2 * PH_PER_LAYER + 1;


template <int PH>
__device__ __forceinline__ void run_phase(const Params& p, LAS unsigned char* lds) {
    unsigned char* ws = p.ws; const int G = gridDim.x, c = blockIdx.x;
    constexpr int l = PH / PH_PER_LAYER, q = PH - l * PH_PER_LAYER;
    if constexpr (PH == 2 * PH_PER_LAYER) { norm_rows2<true>(p.out, p.out + O_YS, p.in[I_NFIN], nullptr, (const float*)(ws + OFF_BIG), nullptr, p.out); }
    else if constexpr (q == 0) phase_prep(p, l, lds);
    else if constexpr (q == 1) { pg8::TileOrder S{(const char*)(ws + OFF_H), (const char*)(ws + OFF_WIN), DM, DM, M_TOK / 256, NPROJ / 256, G, c, DM / 64};
              pg8::EpiBf16<0> E{(bf16_t*)(ws + OFF_PROJ), NPROJ}; pg8::gemm_phase(lds, DM, DM, DM, S, E); }
    else if constexpr (q == 2) phase_stepA(p, l, lds);
    else if constexpr (q == 3) phase_scan(p, l, lds);
    else if constexpr (q == 4) phase_stepC(p, l, lds);
    else if constexpr (q == 5) { pg8::BranchOrder S{(const char*)(ws + OFF_OCAT), (const char*)(ws + OFF_WBR), M_TOK / 256, NMG / 256, G, c};
              pg8::EpiBf16<0> E{(bf16_t*)(ws + OFF_PB), NMG}; pg8::gemm_phase(lds, DM, 512, 512, S, E); }
    else if constexpr (q == 6) { pg8::TileOrder S{(const char*)(ws + OFF_H), (const char*)(ws + OFF_WMG), DM, DM, M_TOK / 256, NMG / 256, G, c, DM / 64};
              pg8::EpiMerge E{(const bf16_t*)(ws + OFF_PB), (bf16_t*)(ws + OFF_OCAT)}; pg8::gemm_phase(lds, DM, DM, DM, S, E); }
    else if constexpr (q == 7) { pg8::SplitOrder S{(const char*)(ws + OFF_OCAT), (const char*)(ws + OFF_WOUT), DM, DM, G, c, DM / 64};
              pg8::EpiResid E{l == 0 ? p.in[I_XP] : p.out, l == 0 ? p.in[I_XS] : p.out + O_YS, p.out, (float*)(ws + OFF_BIG)}; pg8::gemm_phase(lds, DM, DM, DM, S, E); }
    else if constexpr (q == 8) norm_rows2(p.out, l == 0 ? p.in[I_XS] : p.out + O_YS, p.in[I_NFG] + l * DM, (bf16_t*)(ws + OFF_H), (const float*)(ws + OFF_BIG), p.out);
    else if constexpr (q == 9) { pg8::FfnOrder S{(const char*)(ws + OFF_H), (const char*)(ws + OFF_WFI), G, c};
              pg8::EpiFfn E{(bf16_t*)(ws + OFF_ACT), (bf16_t*)(ws + OFF_HALO), p.in[I_FCW] + (size_t)l * 3 * DFF, p.in[I_FCB] + (size_t)l * DFF, (float*)(ws + OFF_PARTF)}; pg8::gemm_phase(lds, DM, DM, DM, S, E); }
    else if constexpr (q == 10) phase_ffn_fix(p, l);
    else { pg8::SplitOrder S{(const char*)(ws + OFF_ACT), (const char*)(ws + OFF_WFO), DFF, DFF, G, c, DFF / 64};
               pg8::EpiResid E{p.out, p.out + O_YS, p.out, (float*)(ws + OFF_BIG)}; pg8::gemm_phase(lds, DFF, DFF, DFF, S, E); }
}

__global__ void __launch_bounds__(512, 2) fwd_kernel(Params p, int ph_lo, int ph_hi) {
    extern __shared__ __attribute__((aligned(16))) unsigned char shm[];
    LAS unsigned char* lds = (LAS unsigned char*)shm;
    volatile LAS unsigned* stw = (volatile LAS unsigned*)(lds + LDS_BYTES - 16);
    if (threadIdx.x == 0) { stw[0] = 0u; stw[1] = 0u; }
    __syncthreads();
    XcdBarrier xb{(unsigned*)(p.ws + OFF_BAR), 0u, stw};
    if (ph_hi - ph_lo > 1) xb = xcd_barrier_post((unsigned*)(p.ws + OFF_BAR), stw);
    if (ph_lo < 0) { __threadfence(); cg::this_grid().sync(); }
#define RUN(PH) if (ph_lo <= PH && PH < ph_hi) { run_phase<PH>(p, lds); if (PH + 1 < ph_hi) xcd_barrier(xb); }
    RUN(0) RUN(1) RUN(2) RUN(3) RUN(4) RUN(5) RUN(6) RUN(7) RUN(8) RUN(9) RUN(10) RUN(11)
    RUN(12) RUN(13) RUN(14) RUN(15) RUN(16) RUN(17) RUN(18) RUN(19) RUN(20) RUN(21) RUN(22) RUN(23) RUN(24)
#undef RUN
}

extern "C" void kernel_launch(void* const* d_in, const int* in_sizes, int n_in, void* d_out, int out_size, void* d_ws, size_t ws_size, hipStream_t stream) {
    static int grid = 0;
    if (grid == 0) {
        if (n_in != 29 || (size_t)out_size != O_END || ws_size < WS_TOTAL) { fprintf(stderr, "kernel_launch: unexpected shapes n_in %d out %d ws %zu (need %zu)\n", n_in, out_size, ws_size, (size_t)WS_END); grid = -1; return; }
        int dev = 0, cus = 0, per_cu = 0;
        (void)hipGetDevice(&dev); (void)hipDeviceGetAttribute(&cus, hipDeviceAttributeMultiprocessorCount, dev);
        if (hipFuncSetAttribute((const void*)fwd_kernel, hipFuncAttributeMaxDynamicSharedMemorySize, LDS_BYTES) != hipSuccess) { fprintf(stderr, "kernel_launch: hipFuncSetAttribute failed\n"); grid = -1; return; }
        if (hipOccupancyMaxActiveBlocksPerMultiprocessor(&per_cu, (const void*)fwd_kernel, 512, LDS_BYTES) != hipSuccess || per_cu < 1) { fprintf(stderr, "kernel_launch: occupancy query says %d\n", per_cu); per_cu = 1; }
        (void)hipGetLastError();
        grid = cus;
        if (grid < 128) grid = -1;
    }
    if (grid < 0) return;
    Params p{};
    for (int i = 0; i < 29; ++i) p.in[i] = (const float*)d_in[i];
    p.out = (float*)d_out; p.ws = (unsigned char*)d_ws;
#if MK_MULTI
    for (int ph = 0; ph < N_PHASES; ++ph) hipLaunchKernelGGL(fwd_kernel, dim3(grid), dim3(512), LDS_BYTES, stream, p, ph, ph + 1);
#else
    (void)hipMemsetAsync((unsigned char*)d_ws + OFF_BAR, 0, XCD_BAR_WORDS * 4, stream);
    int lo = 0, hi = N_PHASES;
    void* args[] = {&p, &lo, &hi};
    hipError_t e = hipLaunchCooperativeKernel((const void*)fwd_kernel, dim3(grid), dim3(512), args, LDS_BYTES, stream);
    if (e != hipSuccess) fprintf(stderr, "cooperative launch failed: %s (grid %d)\n", hipGetErrorString(e), grid);
#endif
}
```

```cpp
#include <hip/hip_runtime.h>
#include <hip/hip_cooperative_groups.h>
#include <cstdio>
namespace cg = cooperative_groups;

#ifndef MK_MULTI
#define MK_MULTI 0
#endif

#define LAS __attribute__((address_space(3)))
typedef unsigned short bf16_t;
typedef short bf16x8 __attribute__((ext_vector_type(8)));
typedef float f32x4 __attribute__((ext_vector_type(4)));
typedef unsigned u32x4 __attribute__((ext_vector_type(4)));
typedef unsigned u32x2 __attribute__((ext_vector_type(2)));

constexpr int M_TOK = 18432, DM = 2048, NPROJ = 7936, NMG = 8192, DFF = 5504, NFI = 11008, NIN = 15896;
constexpr int NCHUNK = 288, NITEM = 1152;
constexpr int PROMPT_ROWS = 16384;
constexpr int C_GLA_Q = 0, C_GLA_K = 256, C_GLA_V = 512, C_GLA_G = 1024, C_HG_Q = 1536, C_HG_F = 2048, C_HG_I = 2560, C_HG_G = 3072,
              C_GDN_QKV = 3584, C_GDN_Z = 5120, C_RET_Q = 5632, C_RET_K = 6144, C_RET_V = 6656, C_RET_G = 7168, C_GLA_LR = 7680,
              C_GDN_B = 7696, C_GDN_A = 7700;
constexpr size_t SZ_WIN = (size_t)NPROJ * DM * 2, SZ_WMG = (size_t)NMG * DM * 2, SZ_WBR = (size_t)4 * DM * 512 * 2, SZ_WOUT = (size_t)DM * DM * 2,
                 SZ_WFI = (size_t)NFI * DM * 2, SZ_WFO = (size_t)DM * DFF * 2, SZ_H = (size_t)M_TOK * DM * 2;
constexpr size_t OFF_WIN = 0, OFF_WMG = OFF_WIN + SZ_WIN, OFF_WBR = OFF_WMG + SZ_WMG, OFF_WOUT = OFF_WBR + SZ_WBR, OFF_WFI = OFF_WOUT + SZ_WOUT,
                 OFF_WFO = OFF_WFI + SZ_WFI, OFF_H = OFF_WFO + SZ_WFO, OFF_OCAT = OFF_H + SZ_H, OFF_BIG = OFF_OCAT + SZ_H;
constexpr size_t OFF_PROJ = OFF_BIG, SZ_PROJ = (size_t)M_TOK * NPROJ * 2;
constexpr size_t OFF_ST_GLA = OFF_PROJ + SZ_PROJ, SZ_ST64 = (size_t)NITEM * 128 * 64 * 2, SZ_ST128 = (size_t)NITEM * 128 * 128 * 2;
constexpr size_t OFF_ST_HG = OFF_ST_GLA + SZ_ST64, OFF_ST_RET = OFF_ST_HG + SZ_ST128, OFF_ST_GDN = OFF_ST_RET + SZ_ST128, OFF_A_GDN = OFF_ST_GDN + SZ_ST128,
                 OFF_GQX = OFF_A_GDN + SZ_ST128, OFF_GO0 = OFF_GQX + SZ_ST64, OFF_DEC_GLA = OFF_GO0 + SZ_ST64, OFF_DEC_HG = OFF_DEC_GLA + (size_t)NITEM * 64 * 4,
                 OFF_MIX_END = OFF_DEC_HG + (size_t)NITEM * 128 * 4;
constexpr size_t OFF_PB = OFF_BIG;
constexpr size_t OFF_AU = OFF_BIG, OFF_PARTF = OFF_AU + (size_t)64 * 1024 * 1024  , OFF_HALO = OFF_AU + (size_t)128 * 1024 * 1024, OFF_ACT = OFF_AU + (size_t)M_TOK * NFI * 2, WS_END = OFF_ACT + (size_t)M_TOK * DFF * 2;
constexpr size_t O_YP = 0, O_YS = 33554432, O_PGLA = O_YS + 4194304, O_PHG = O_PGLA + 131072, O_PGDN = O_PHG + 262144, O_PRET = O_PGDN + 262144,
                 O_PGC = O_PRET + 262144, O_PFC = O_PGC + 18432, O_SGLA = O_PFC + 44032, O_SHG = O_SGLA + 2097152, O_SGDN = O_SHG + 4194304,
                 O_SRET = O_SGDN + 4194304, O_SGC = O_SRET + 4194304, O_SFC = O_SGC + 294912, O_END = O_SFC + 704512;
constexpr size_t OFF_BAR = WS_END, WS_TOTAL = WS_END + 16384;
constexpr int LDS_BYTES = 147456;

enum { I_XP = 0, I_XS, I_SGLA, I_SHG, I_SGDN, I_SRET, I_CGDN, I_CFFN, I_NMG, I_WIN, I_WGK, I_BGK, I_GLANG, I_LB, I_HGNG, I_GCW, I_ALOG, I_DTB, I_GDNNG,
       I_RETNG, I_RETNB, I_WBR, I_WOUT, I_NFG, I_WFI, I_FCW, I_FCB, I_WFO, I_NFIN };

struct Params { const float* in[29]; float* out; unsigned char* ws; };

typedef __bf16 bf16x2_t __attribute__((ext_vector_type(2)));
typedef float f32x2_t __attribute__((ext_vector_type(2)));
__device__ __forceinline__ unsigned cvt_pk_bf16(float lo, float hi) { f32x2_t f = {lo, hi}; bf16x2_t r = __builtin_convertvector(f, bf16x2_t); return __builtin_bit_cast(unsigned, r); }
__device__ __forceinline__ bf16_t f2bf(float f) { return (bf16_t)(cvt_pk_bf16(f, 0.f) & 0xffffu); }
__device__ __forceinline__ float bf2f(bf16_t b) { return __uint_as_float(((unsigned)b) << 16); }
__device__ __forceinline__ float bflo(unsigned w) { return __uint_as_float(w << 16); }
__device__ __forceinline__ float bfhi(unsigned w) { return __uint_as_float(w & 0xffff0000u); }
__device__ __forceinline__ void unpack8(u32x4 w, float* f) { f[0] = bflo(w[0]); f[1] = bfhi(w[0]); f[2] = bflo(w[1]); f[3] = bfhi(w[1]); f[4] = bflo(w[2]); f[5] = bfhi(w[2]); f[6] = bflo(w[3]); f[7] = bfhi(w[3]); }
__device__ __forceinline__ u32x4 pack8(const float* f) { u32x4 w; w[0] = cvt_pk_bf16(f[0], f[1]); w[1] = cvt_pk_bf16(f[2], f[3]); w[2] = cvt_pk_bf16(f[4], f[5]); w[3] = cvt_pk_bf16(f[6], f[7]); return w; }
__device__ __forceinline__ float sigm(float x) { return __builtin_amdgcn_rcpf(1.f + __expf(-x)); }
__device__ __forceinline__ float silu(float x) { return x * __builtin_amdgcn_rcpf(1.f + __expf(-x)); }
__device__ __forceinline__ float expc(float x) { return __expf(fminf(x, 80.f)); }
__device__ __forceinline__ float logsig(float x) { return fminf(x, 0.f) - log1pf(__expf(-fabsf(x))); }
__device__ __forceinline__ float softplus(float x) { return fmaxf(x, 0.f) + log1pf(__expf(-fabsf(x))); }

__device__ __forceinline__ void lds_barrier() { asm volatile("s_waitcnt lgkmcnt(0)" ::: "memory"); __builtin_amdgcn_s_barrier(); asm volatile("" ::: "memory"); }

struct ChunkInfo { int row0; int first, last, sample, b; float pos0; };
__device__ __forceinline__ ChunkInfo chunk_info(int cgi) {
    ChunkInfo c; c.row0 = cgi * 64;
    if (cgi < 256) { const int ci = cgi & 127; c.sample = 0; c.b = cgi >> 7; c.first = (ci == 0); c.last = (ci == 127); c.pos0 = (float)(ci * 64); }
    else { c.sample = 1; c.b = cgi - 256; c.first = 1; c.last = 1; c.pos0 = 4096.f; }
    return c;
}

namespace pg8 {
constexpr int BM = 256, BK = 64, HALF = 128, HTB = HALF * BK * 2, STAGE_BYTES = 8 * HTB, NXCD = 8, WGM = 8;
__device__ __forceinline__ int lds_byte(int r, int c) { const int st = (r >> 4) * 2 + (c >> 5), rr = r & 15, cc = c & 31, ob = rr * 64 + cc * 2; return st * 1024 + (ob ^ (((ob >> 9) & 1) << 5)); }
__device__ __forceinline__ void stage_rc(int b, int& R, int& C) { const int st = b / 1024, sb = b % 1024, swz = sb ^ (((sb >> 9) & 1) << 5); R = (st >> 1) * 16 + swz / 64; C = (st & 1) * 32 + (swz % 64) / 2; }
__device__ __forceinline__ int perm32(int rho) { const int n = rho >> 4, i = rho & 15; return 8 * (i >> 2) + 4 * n + (i & 3); }
struct Unit { int pm, pn, aux, nt; const char* a; const char* b; };
__device__ __forceinline__ void tile_of(int L, int nM, int nN, int& pm, int& pn) {
    const int nwg = nM * nN; int wgid = L;
    { const int q = nwg / NXCD, r = nwg % NXCD, xcd = wgid % NXCD, off = wgid / NXCD; wgid = (xcd < r ? xcd * (q + 1) : r * (q + 1) + (xcd - r) * q) + off; }
    const int nig = WGM * nN, gid = wgid / nig, fm = gid * WGM, gsz = (nM - fm) < WGM ? (nM - fm) : WGM;
    pm = fm + ((wgid % nig) % gsz); pn = (wgid % nig) / gsz;
}
struct TileOrder {
    const char* A; const char* B; int lda, ldb, nM, nN, G, c, nt;
    __device__ __forceinline__ bool next(int i, Unit& u) const {
        const long L = (long)i * G + c; if (L >= (long)nM * nN) return false;
        tile_of((int)L, nM, nN, u.pm, u.pn); u.aux = 0; u.nt = nt;
        u.a = A + (size_t)u.pm * 256 * lda * 2; u.b = B + (size_t)u.pn * 256 * ldb * 2; return true;
    }
};
struct BranchOrder {
    const char* A; const char* B; int nM, nN, G, c;
    __device__ __forceinline__ bool next(int i, Unit& u) const {
        const long L = (long)i * G + c; if (L >= (long)nM * nN) return false;
        tile_of((int)L, nM, nN, u.pm, u.pn); u.aux = 0; u.nt = 8;
        const int n = u.pn >> 3, pn = u.pn & 7;
        u.a = A + ((size_t)u.pm * 256 * DM + (size_t)n * 512) * 2; u.b = B + ((size_t)n * DM * 512 + (size_t)pn * 256 * 512) * 2; return true;
    }
};

struct SplitOrder {
    const char* A; const char* B; int lda, ldb, G, c, nt;
    __device__ __forceinline__ bool next(int i, Unit& u) const {
        if (G != 256) { const long L = (long)i * G + c; if (L >= 576) return false; tile_of((int)L, 72, 8, u.pm, u.pn); u.aux = 0; u.nt = nt;
            u.a = A + (size_t)u.pm * 256 * lda * 2; u.b = B + (size_t)u.pn * 256 * ldb * 2; return true; }
        if (i < 2) { tile_of(i * 256 + c, 64, 8, u.pm, u.pn); u.aux = 0; u.nt = nt; u.a = A + (size_t)u.pm * 256 * lda * 2; u.b = B + (size_t)u.pn * 256 * ldb * 2; return true; }
        if (i > 2) return false;
        const int j = c >> 2, q = c & 3, per = ((nt / 4 + 1) / 2) * 2, kt0 = q * per;
        u.pm = 64 + (j >> 3); u.pn = j & 7; u.aux = 1 + q; u.nt = min(per, nt - kt0);
        u.a = A + (size_t)u.pm * 256 * lda * 2 + (size_t)kt0 * 128; u.b = B + (size_t)u.pn * 256 * ldb * 2 + (size_t)kt0 * 128; return true;
    }
};

constexpr int FFN_SPLIT_PM0 = 48, FFN_SPLIT_PN = 42;
struct FfnOrder {
    const char* A; const char* B; int G, c;
    __device__ __forceinline__ bool next(int i, Unit& u) const {
        if (G != 256) { const long L = (long)i * G + c; if (L >= 72 * 43) return false; tile_of((int)L, 72, 43, u.pm, u.pn); u.aux = 0; u.nt = DM / 64;
            u.a = A + (size_t)u.pm * 256 * DM * 2; u.b = B + (size_t)u.pn * 256 * DM * 2; return true; }
        if (i < 12) { const int L = i * 256 + c;
            if (L < 72 * 42) tile_of(L, 72, 42, u.pm, u.pn); else { u.pm = L - 72 * 42; u.pn = FFN_SPLIT_PN; }
            u.aux = 0; u.nt = DM / 64; u.a = A + (size_t)u.pm * 256 * DM * 2; u.b = B + (size_t)u.pn * 256 * DM * 2; return true; }
        if (i > 12 || c >= 96) return false;
        const int j = c >> 2, q = c & 3;
        u.pm = FFN_SPLIT_PM0 + j; u.pn = FFN_SPLIT_PN; u.aux = 1 + q; u.nt = 8;
        u.a = A + (size_t)u.pm * 256 * DM * 2 + (size_t)q * 8 * 128; u.b = B + (size_t)u.pn * 256 * DM * 2 + (size_t)q * 8 * 128; return true;
    }
};

template <class Epi, class Sched>
__device__ __forceinline__ void gemm_phase(LAS unsigned char* lds, const int lda, const int ldb, const int K, const Sched& S, const Epi& E) {
    const int tid = threadIdx.x, wid = __builtin_amdgcn_readfirstlane(tid >> 6), lane = tid & 63, wr = wid >> 2, wc = wid & 3, fr = lane & 15, fq = lane >> 4;
    unsigned voffA[2], voffB[2];
#pragma unroll
    for (int i = 0; i < 2; ++i) { int R, C; stage_rc(tid * 16 + i * 8192, R, C); const int Rb = Epi::PERM ? ((R & ~31) + perm32(R & 31)) : R;
        voffA[i] = (unsigned)(R * lda + C) * 2u; voffB[i] = (unsigned)(Rb * ldb + C) * 2u; }
    const size_t kstep = (size_t)(BK * 2);
    const size_t hstepA = (size_t)HALF * lda * 2, hstepB = (size_t)HALF * ldb * 2;
    const unsigned ldsw = (unsigned)wid * 1024u;
    const int aoff = lds_byte(wr * 64 + fr, fq * 8), boff = lds_byte(wc * 32 + fr, fq * 8);
#define PG8_SA(b, h) (((b) * 2 + (h)) * HTB)
#define PG8_SB(b, h) ((4 + (b) * 2 + (h)) * HTB)
#define PG8_STAGE(bufoff, gbase, voff) do { _Pragma("unroll") for (int _i = 0; _i < 2; ++_i) \
        __builtin_amdgcn_global_load_lds((const unsigned*)((const char*)(gbase) + (voff)[_i]), (LAS unsigned*)(lds + (bufoff) + ldsw + _i * 8192), 16, 0, 0); } while (0)
#define PG8_LDA(dst, b, h) do { _Pragma("unroll") for (int m = 0; m < 4; ++m) _Pragma("unroll") for (int k = 0; k < 2; ++k) dst[m][k] = *(const LAS bf16x8*)(lds + PG8_SA(b, h) + aoff + m * 2048 + k * 1024); } while (0)
#define PG8_LDB(dst, b, h) do { _Pragma("unroll") for (int n = 0; n < 2; ++n) _Pragma("unroll") for (int k = 0; k < 2; ++k) dst[n][k] = *(const LAS bf16x8*)(lds + PG8_SB(b, h) + boff + n * 2048 + k * 1024); } while (0)
#define PG8_MMA(ai, bj, At, Bt) do { __builtin_amdgcn_s_setprio(1); _Pragma("unroll") for (int m = 0; m < 4; ++m) _Pragma("unroll") for (int n = 0; n < 2; ++n) _Pragma("unroll") for (int k = 0; k < 2; ++k) \
        acc[ai][bj][m][n] = __builtin_amdgcn_mfma_f32_16x16x32_bf16(Bt[n][k], At[m][k], acc[ai][bj][m][n], 0, 0, 0); __builtin_amdgcn_s_setprio(0); } while (0)
#define PG8_WAIT_V(n) asm volatile("s_waitcnt vmcnt(" #n ")" ::: "memory")
#define PG8_WAIT_L(n) asm volatile("s_waitcnt lgkmcnt(" #n ")" ::: "memory")
#define PG8_BAR __builtin_amdgcn_s_barrier()
#define PG8_SCHED __builtin_amdgcn_sched_barrier(0)
    Unit cur, nxt; int ui = 0;
    if (!S.next(0, cur)) return;
    f32x4 acc[2][2][4][2];
#pragma unroll
    for (int a = 0; a < 2; ++a)
#pragma unroll
        for (int b = 0; b < 2; ++b)
#pragma unroll
            for (int m = 0; m < 4; ++m)
#pragma unroll
                for (int n = 0; n < 2; ++n) acc[a][b][m][n] = (f32x4){0.f, 0.f, 0.f, 0.f};
    bf16x8 At[4][2], B0[2][2], B1[2][2];
    const char* cA = cur.a; const char* cB = cur.b;
    PG8_STAGE(PG8_SB(0, 0), cB, voffB); PG8_STAGE(PG8_SA(0, 0), cA, voffA); PG8_STAGE(PG8_SB(0, 1), cB + hstepB, voffB); PG8_STAGE(PG8_SA(0, 1), cA + hstepA, voffA);
    if (wr == 1) PG8_BAR;
    PG8_WAIT_V(4); PG8_BAR;
    PG8_STAGE(PG8_SB(1, 0), cB + kstep, voffB); PG8_STAGE(PG8_SA(1, 0), cA + kstep, voffA); PG8_STAGE(PG8_SB(1, 1), cB + hstepB + kstep, voffB);
    PG8_WAIT_V(6); PG8_BAR;
    for (;;) {
        const bool has_next = S.next(ui + 1, nxt);
        const char* nA = has_next ? nxt.a : cA; const char* nB = has_next ? nxt.b : cB;
        const int cnt = cur.nt;
        for (int t = 0; t < cnt; t += 2) {
            const bool last = (t == cnt - 2);
            const char* a1 = cA + (size_t)(t + 1) * kstep;
            const char* a2 = last ? nA : cA + (size_t)(t + 2) * kstep; const char* b2 = last ? nB : cB + (size_t)(t + 2) * kstep;
            const char* a3 = a2 + kstep; const char* b3 = b2 + kstep;
            PG8_LDB(B0, 0, 0); PG8_SCHED; PG8_LDA(At, 0, 0); PG8_STAGE(PG8_SA(1, 1), a1 + hstepA, voffA);
            PG8_WAIT_L(8); PG8_BAR; PG8_WAIT_L(0); PG8_MMA(0, 0, At, B0); PG8_BAR; PG8_SCHED;
            PG8_LDB(B1, 0, 1); PG8_STAGE(PG8_SB(0, 0), b2, voffB);
            PG8_BAR; PG8_WAIT_L(0); PG8_MMA(0, 1, At, B1); PG8_BAR;
            PG8_LDA(At, 0, 1); PG8_STAGE(PG8_SA(0, 0), a2, voffA);
            PG8_BAR; PG8_WAIT_L(0); PG8_MMA(1, 0, At, B0); PG8_BAR; PG8_SCHED;
            PG8_STAGE(PG8_SB(0, 1), b2 + hstepB, voffB);
            PG8_WAIT_V(6); PG8_BAR; PG8_MMA(1, 1, At, B1); PG8_BAR;
            PG8_LDB(B0, 1, 0); PG8_SCHED; PG8_LDA(At, 1, 0); PG8_STAGE(PG8_SA(0, 1), a2 + hstepA, voffA);
            PG8_WAIT_L(8); PG8_BAR; PG8_WAIT_L(0); PG8_MMA(0, 0, At, B0); PG8_BAR; PG8_SCHED;
            PG8_LDB(B1, 1, 1); PG8_STAGE(PG8_SB(1, 0), b3, voffB);
            PG8_BAR; PG8_WAIT_L(0); PG8_MMA(0, 1, At, B1); PG8_BAR;
            PG8_LDA(At, 1, 1); PG8_STAGE(PG8_SA(1, 0), a3, voffA);
            PG8_BAR; PG8_WAIT_L(0); PG8_MMA(1, 0, At, B0); PG8_BAR; PG8_SCHED;
            PG8_STAGE(PG8_SB(1, 1), b3 + hstepB, voffB);
            PG8_WAIT_V(6); PG8_BAR; PG8_MMA(1, 1, At, B1); PG8_BAR;
        }
        E(acc, cur, wr, wc, fr, fq);
        if (!has_next) break;
#pragma unroll
        for (int a = 0; a < 2; ++a)
#pragma unroll
            for (int b = 0; b < 2; ++b)
#pragma unroll
                for (int m = 0; m < 4; ++m)
#pragma unroll
                    for (int n = 0; n < 2; ++n) acc[a][b][m][n] = (f32x4){0.f, 0.f, 0.f, 0.f};
        cur = nxt; cA = nA; cB = nB; ++ui;
    }
    PG8_WAIT_V(0);
    if (wr == 0) PG8_BAR;
    PG8_BAR;
#undef PG8_SA
#undef PG8_SB
#undef PG8_STAGE
#undef PG8_LDA
#undef PG8_LDB
#undef PG8_MMA
#undef PG8_WAIT_V
#undef PG8_WAIT_L
#undef PG8_BAR
#undef PG8_SCHED
}

template <int ACT> struct EpiBf16 {
    static constexpr bool PERM = true;
    bf16_t* O; int ldc;
    __device__ __forceinline__ void operator()(const f32x4 (&acc)[2][2][4][2], const Unit& u, int wr, int wc, int fr, int fq) const {
        const int row0 = u.pm * BM + wr * 64 + fr, col0 = u.pn * BM + wc * 32 + 8 * fq;
#pragma unroll
        for (int ai = 0; ai < 2; ++ai)
#pragma unroll
            for (int m = 0; m < 4; ++m) { bf16_t* rowp = O + (size_t)(row0 + ai * HALF + m * 16) * ldc + col0;
#pragma unroll
                for (int bj = 0; bj < 2; ++bj) { f32x4 v0 = acc[ai][bj][m][0], v1 = acc[ai][bj][m][1];
                    if (ACT == 1) { for (int j = 0; j < 4; ++j) { v0[j] = sigm(v0[j]); v1[j] = sigm(v1[j]); } }
                    u32x4 w; w[0] = cvt_pk_bf16(v0[0], v0[1]); w[1] = cvt_pk_bf16(v0[2], v0[3]); w[2] = cvt_pk_bf16(v1[0], v1[1]); w[3] = cvt_pk_bf16(v1[2], v1[3]);
                    *(u32x4*)(rowp + bj * HALF) = w; } }
    }
};
struct EpiMerge {
    static constexpr bool PERM = true;
    const bf16_t* pb; bf16_t* mixed;
    __device__ __forceinline__ void operator()(const f32x4 (&acc)[2][2][4][2], const Unit& u, int wr, int wc, int fr, int fq) const {
        const int row0 = u.pm * BM + wr * 64 + fr, d0 = u.pn * 64 + wc * 16 + fq * 4;
        u32x2 pw[2][4][4];
#pragma unroll
        for (int ai = 0; ai < 2; ++ai)
#pragma unroll
            for (int m = 0; m < 4; ++m)
#pragma unroll
                for (int n = 0; n < 4; ++n) pw[ai][m][n] = *(const u32x2*)(pb + (size_t)(row0 + ai * HALF + m * 16) * NMG + n * DM + d0);
#pragma unroll
        for (int ai = 0; ai < 2; ++ai)
#pragma unroll
            for (int m = 0; m < 4; ++m) { const size_t row = (size_t)(row0 + ai * HALF + m * 16);
                float o[4] = {0.f, 0.f, 0.f, 0.f};
#pragma unroll
                for (int n = 0; n < 4; ++n) { const f32x4 a = acc[ai][n >> 1][m][n & 1]; const u32x2 w = pw[ai][m][n];
                    o[0] += sigm(a[0]) * bflo(w[0]); o[1] += sigm(a[1]) * bfhi(w[0]); o[2] += sigm(a[2]) * bflo(w[1]); o[3] += sigm(a[3]) * bfhi(w[1]); }
                u32x2 w; w[0] = cvt_pk_bf16(o[0], o[1]); w[1] = cvt_pk_bf16(o[2], o[3]);
                *(u32x2*)(mixed + row * DM + d0) = w; }
    }
};
__device__ __forceinline__ float dpp_ror1(float x) { return __builtin_bit_cast(float, __builtin_amdgcn_mov_dpp(__builtin_bit_cast(int, x), 0x121, 0xF, 0xF, true)); }
__device__ __forceinline__ float dpp_ror2(float x) { return __builtin_bit_cast(float, __builtin_amdgcn_mov_dpp(__builtin_bit_cast(int, x), 0x122, 0xF, 0xF, true)); }
struct EpiFfn {
    static constexpr bool PERM = true;
    bf16_t* act; bf16_t* halo; const float* cw; const float* cb; float* partf;
    __device__ __forceinline__ void operator()(const f32x4 (&acc)[2][2][4][2], const Unit& u, int wr, int wc, int fr, int fq) const {
        if (u.aux) {
            float* pq = partf + ((size_t)(u.aux - 1) * 24 + (u.pm - FFN_SPLIT_PM0)) * 65536;
#pragma unroll
            for (int ai = 0; ai < 2; ++ai)
#pragma unroll
                for (int m = 0; m < 4; ++m)
#pragma unroll
                    for (int bj = 0; bj < 2; ++bj)
#pragma unroll
                        for (int n = 0; n < 2; ++n) *(f32x4*)(pq + (size_t)(ai * HALF + wr * 64 + 16 * m + fr) * 256 + bj * HALF + wc * 32 + 8 * fq + 4 * n) = acc[ai][bj][m][n];
            return;
        }
        const int j0 = u.pn * 128 + wc * 32 + 8 * fq;
        float w0[8], w1[8], w2[8], bb[8];
#pragma unroll
        for (int c = 0; c < 8; c += 4) { const float4 a = *(const float4*)(cw + j0 + c), b = *(const float4*)(cw + DFF + j0 + c), d = *(const float4*)(cw + 2 * DFF + j0 + c), e = *(const float4*)(cb + j0 + c);
            w0[c] = a.x; w0[c + 1] = a.y; w0[c + 2] = a.z; w0[c + 3] = a.w; w1[c] = b.x; w1[c + 1] = b.y; w1[c + 2] = b.z; w1[c + 3] = b.w;
            w2[c] = d.x; w2[c + 1] = d.y; w2[c + 2] = d.z; w2[c + 3] = d.w; bb[c] = e.x; bb[c + 1] = e.y; bb[c + 2] = e.z; bb[c + 3] = e.w; }
#pragma unroll
        for (int ai = 0; ai < 2; ++ai) {
            const int R0 = u.pm * BM + ai * HALF + wr * 64, cgi = R0 >> 6;
            float p1[8], p2[8];
#pragma unroll
            for (int e = 0; e < 8; ++e) { p1[e] = 0.f; p2[e] = 0.f; }
#pragma unroll
            for (int m = 0; m < 4; ++m) {
                const size_t row = (size_t)(R0 + 16 * m + fr);
                float y[8], ac[8], uc[8];
#pragma unroll
                for (int e = 0; e < 8; ++e) {
                    const float a = acc[ai][0][m][e >> 2][e & 3], uu = acc[ai][1][m][e >> 2][e & 3];
                    const float r1c = dpp_ror1(a), r2c = dpp_ror2(a);
                    const float a1 = (fr >= 1) ? r1c : p1[e], a2 = (fr >= 2) ? r2c : p2[e];
                    p1[e] = r1c; p2[e] = r2c;
                    y[e] = silu(w0[e] * a2 + w1[e] * a1 + w2[e] * a + bb[e]) * uu; ac[e] = a; uc[e] = uu;
                }
                if (m > 0 || fr >= 2) *(u32x4*)(act + row * DFF + j0) = pack8(y);
                const int slot = (m == 0 && fr < 2) ? fr : ((m == 3 && fr >= 14) ? fr - 12 : -1);
                if (slot >= 0) { bf16_t* hp = halo + ((size_t)(cgi * 4 + slot) * 2) * DFF + j0; *(u32x4*)hp = pack8(ac); *(u32x4*)(hp + DFF) = pack8(uc); }
            }
        }
    }
};
struct EpiResid {
    static constexpr bool PERM = false;
    const float* xin_p; const float* xin_s; float* xout; float* part;
    __device__ __forceinline__ void operator()(const f32x4 (&acc)[2][2][4][2], const Unit& u, int wr, int wc, int fr, int fq) const {
        const int row0 = u.pm * BM + wr * 64 + fr, col0 = u.pn * BM + wc * 32 + 4 * fq;
        if (u.aux == 0) {
            const float* xin = (u.pm * BM < PROMPT_ROWS) ? xin_p : (xin_s - (size_t)PROMPT_ROWS * DM);
#pragma unroll
            for (int ai = 0; ai < 2; ++ai) {
                f32x4 xv[4][2][2];
#pragma unroll
                for (int m = 0; m < 4; ++m)
#pragma unroll
                    for (int bj = 0; bj < 2; ++bj)
#pragma unroll
                        for (int n = 0; n < 2; ++n) xv[m][bj][n] = *(const f32x4*)(xin + (size_t)(row0 + ai * HALF + m * 16) * DM + col0 + bj * HALF + n * 16);
#pragma unroll
                for (int m = 0; m < 4; ++m)
#pragma unroll
                    for (int bj = 0; bj < 2; ++bj)
#pragma unroll
                        for (int n = 0; n < 2; ++n) *(f32x4*)(xout + (size_t)(row0 + ai * HALF + m * 16) * DM + col0 + bj * HALF + n * 16) = acc[ai][bj][m][n] + xv[m][bj][n];
            }
        } else {
            float* pq = part + (size_t)(u.aux - 1) * 2048 * DM - (size_t)PROMPT_ROWS * DM;
#pragma unroll
            for (int ai = 0; ai < 2; ++ai)
#pragma unroll
                for (int m = 0; m < 4; ++m) { const size_t ro = (size_t)(row0 + ai * HALF + m * 16) * DM + col0;
#pragma unroll
                    for (int bj = 0; bj < 2; ++bj)
#pragma unroll
                        for (int n = 0; n < 2; ++n) *(f32x4*)(pq + ro + bj * HALF + n * 16) = acc[ai][bj][m][n]; }
        }
    }
};
}

__device__ __forceinline__ int swz64(int row, int col, int ld) { return row * ld + ((((col >> 3) ^ ((row >> 4) & 7)) << 3) | (col & 7)); }
template <bool SWX = false, bool SWY = false, class F>
__device__ __forceinline__ void lds_mm(const LAS bf16_t* X, int ldx, const LAS bf16_t* Y, int ldy, int MB, int NB, int ksteps, F&& epi) {
    int tidl = threadIdx.x; asm volatile("" : "+v"(tidl));
    const int wid = tidl >> 6, lane = tidl & 63, fr = lane & 15, fq = lane >> 4;
    for (int blk = wid; blk < MB * NB; blk += 8) {
        const int mb = blk / NB, nb = blk - mb * NB;
        f32x4 a00 = {0.f, 0.f, 0.f, 0.f}, a01 = a00, a10 = a00, a11 = a00;
        const LAS bf16_t* xp = X + (mb * 32 + fr) * ldx;
        const LAS bf16_t* yp = Y + (nb * 32 + fr) * ldy;
        const int sx0 = SWX ? ((2 * mb) & 7) : 0, sx1 = SWX ? ((2 * mb + 1) & 7) : 0, sy0 = SWY ? ((2 * nb) & 7) : 0, sy1 = SWY ? ((2 * nb + 1) & 7) : 0;
        for (int k = 0; k < ksteps; ++k) {
            const int g = fq + 4 * k;
            const bf16x8 x0 = *(const LAS bf16x8*)(xp + ((g ^ sx0) << 3)), x1 = *(const LAS bf16x8*)(xp + 16 * ldx + ((g ^ sx1) << 3));
            const bf16x8 y0 = *(const LAS bf16x8*)(yp + ((g ^ sy0) << 3)), y1 = *(const LAS bf16x8*)(yp + 16 * ldy + ((g ^ sy1) << 3));
            a00 = __builtin_amdgcn_mfma_f32_16x16x32_bf16(y0, x0, a00, 0, 0, 0);
            a01 = __builtin_amdgcn_mfma_f32_16x16x32_bf16(y1, x0, a01, 0, 0, 0);
            a10 = __builtin_amdgcn_mfma_f32_16x16x32_bf16(y0, x1, a10, 0, 0, 0);
            a11 = __builtin_amdgcn_mfma_f32_16x16x32_bf16(y1, x1, a11, 0, 0, 0);
        }
        const int r = mb * 32 + fr, c = nb * 32 + fq * 4;
        epi(r, c, a00); epi(r, c + 16, a01); epi(r + 16, c, a10); epi(r + 16, c + 16, a11);
    }
}

__device__ __forceinline__ int merge_row(int cidx) { const int n = cidx >> 11, d = cidx & 2047, dl = d & 63; return (d >> 6) * 256 + (n >> 1) * 128 + (dl >> 4) * 32 + ((dl >> 2) & 3) * 8 + (n & 1) * 4 + (dl & 3); }
template <int MAP = 0>
__device__ __forceinline__ void conv_job(const float* __restrict__ src, int sld, int K, int scol0, int ncols, bf16_t* dst, int dld, int drow0, LAS unsigned* tl, int& rot, int first = 0, int cnt = 0) {
    const int nk = K / 64, nn = (ncols + 63) / 64, ntiles = nk * nn, G = cnt ? cnt : (int)gridDim.x, tid = threadIdx.x;
    const int kp = tid >> 4, n4 = (tid & 15) * 4, on = tid >> 3, okg = tid & 7;
    int t = ((int)blockIdx.x - first + G - rot) % G;
    float4 r0 = make_float4(0.f, 0.f, 0.f, 0.f), r1 = r0;
    if (t < ntiles) { const int tk = t / nn, tn = t - tk * nn;
        if (n4 < min(64, ncols - tn * 64)) { const float* sp = src + (size_t)(tk * 64 + 2 * kp) * sld + scol0 + tn * 64 + n4; r0 = *(const float4*)sp; r1 = *(const float4*)(sp + sld); } }
    for (; t < ntiles; t += G) {
        const int tk = t / nn, tn = t - tk * nn, k0 = tk * 64, n0 = tn * 64, nvalid = min(64, ncols - n0);
        tl[(n4 + 0) * 33 + kp] = cvt_pk_bf16(r0.x, r1.x); tl[(n4 + 1) * 33 + kp] = cvt_pk_bf16(r0.y, r1.y);
        tl[(n4 + 2) * 33 + kp] = cvt_pk_bf16(r0.z, r1.z); tl[(n4 + 3) * 33 + kp] = cvt_pk_bf16(r0.w, r1.w);
        lds_barrier();
        { const int t2 = t + G; r0 = make_float4(0.f, 0.f, 0.f, 0.f); r1 = r0;
          if (t2 < ntiles) { const int tk2 = t2 / nn, tn2 = t2 - tk2 * nn;
              if (n4 < min(64, ncols - tn2 * 64)) { const float* sp = src + (size_t)(tk2 * 64 + 2 * kp) * sld + scol0 + tn2 * 64 + n4; r0 = *(const float4*)sp; r1 = *(const float4*)(sp + sld); } } }
        if (on < nvalid) { u32x4 v; v[0] = tl[on * 33 + okg * 4]; v[1] = tl[on * 33 + okg * 4 + 1]; v[2] = tl[on * 33 + okg * 4 + 2]; v[3] = tl[on * 33 + okg * 4 + 3];
            int drow = drow0 + n0 + on;
            if (MAP == 1) drow = merge_row(n0 + on);
            if (MAP == 2) { const int sc = n0 + on, j = sc < DFF ? sc : sc - DFF; drow = (j >> 7) * 256 + (sc < DFF ? 0 : 128) + (j & 127); }
            *(u32x4*)(dst + (size_t)drow * dld + k0 + okg * 8) = v; }
        lds_barrier();
    }
    rot = (rot + ntiles) % G;
}

__device__ __forceinline__ float wave_sum(float v) {
#pragma unroll
    for (int o = 32; o >= 1; o >>= 1) v += __shfl_xor(v, o);
    return v;
}

template <bool FINAL>
__device__ __forceinline__ void norm_rows(const float* xp, const float* xs, const float* __restrict__ g, bf16_t* h, float* yout, const float* part, float* xwb) {
    const int wid = threadIdx.x >> 6;
    for (int r = blockIdx.x * 8 + wid; r < M_TOK; r += gridDim.x * 8) {
        int lane = threadIdx.x & 63; asm volatile("" : "+v"(lane));
        const float* xr = (r < PROMPT_ROWS) ? xp + (size_t)r * DM : xs + (size_t)(r - PROMPT_ROWS) * DM;
        float4 v[8], gv[8]; float ss = 0.f;
#pragma unroll
        for (int j = 0; j < 8; ++j) v[j] = *(const float4*)(xr + (j * 64 + lane) * 4);
#pragma unroll
        for (int j = 0; j < 8; ++j) gv[j] = *(const float4*)(g + (j * 64 + lane) * 4);
        if (part != nullptr && r >= PROMPT_ROWS) {
#pragma unroll
            for (int q = 0; q < 4; ++q) { const float* pr = part + ((size_t)q * 2048 + (r - PROMPT_ROWS)) * DM;
#pragma unroll
                for (int j = 0; j < 8; ++j) { const float4 a = *(const float4*)(pr + (j * 64 + lane) * 4); v[j].x += a.x; v[j].y += a.y; v[j].z += a.z; v[j].w += a.w; } }
            if (xwb != nullptr) {
#pragma unroll
                for (int j = 0; j < 8; ++j) *(float4*)(xwb + (size_t)r * DM + (j * 64 + lane) * 4) = v[j]; }
        }
#pragma unroll
        for (int j = 0; j < 8; ++j) ss += v[j].x * v[j].x + v[j].y * v[j].y + v[j].z * v[j].z + v[j].w * v[j].w;
        ss = wave_sum(ss);
        const float rs = rsqrtf(ss * (1.f / DM) + 1e-6f);
#pragma unroll
        for (int j = 0; j < 8; ++j) { const int c = (j * 64 + lane) * 4;
            const float o0 = v[j].x * rs * gv[j].x, o1 = v[j].y * rs * gv[j].y, o2 = v[j].z * rs * gv[j].z, o3 = v[j].w * rs * gv[j].w;
            if (FINAL) *(float4*)(yout + (size_t)r * DM + c) = make_float4(o0, o1, o2, o3);
            else { u32x2 w; w[0] = cvt_pk_bf16(o0, o1); w[1] = cvt_pk_bf16(o2, o3); *(u32x2*)(h + (size_t)r * DM + c) = w; } }
    }
}

template <bool FINAL = false>
__device__ __forceinline__ void norm_rows2(const float* xp, const float* xs, const float* __restrict__ g, bf16_t* h, const float* part, float* xwb, float* yout = nullptr) {
    const int wid = threadIdx.x >> 6, nw = gridDim.x * 8;
    for (int r0 = blockIdx.x * 8 + wid; r0 < M_TOK; r0 += 2 * nw) {
        int lane = threadIdx.x & 63; asm volatile("" : "+v"(lane));
        const int r1 = r0 + nw; const bool ok1 = r1 < M_TOK; const int r1c = ok1 ? r1 : r0;
        const float* xa = (r0 < PROMPT_ROWS) ? xp + (size_t)r0 * DM : xs + (size_t)(r0 - PROMPT_ROWS) * DM;
        const float* xb = (r1c < PROMPT_ROWS) ? xp + (size_t)r1c * DM : xs + (size_t)(r1c - PROMPT_ROWS) * DM;
        float4 va[8], vb[8], gv[8];
#pragma unroll
        for (int j = 0; j < 8; ++j) { va[j] = *(const float4*)(xa + (j * 64 + lane) * 4); vb[j] = *(const float4*)(xb + (j * 64 + lane) * 4); }
#pragma unroll
        for (int j = 0; j < 8; ++j) gv[j] = *(const float4*)(g + (j * 64 + lane) * 4);
#pragma unroll
        for (int q = 0; q < 2; ++q) {
            const int r = q ? r1c : r0;
            if (q == 0 || ok1) {
                float4 v[8];
#pragma unroll
                for (int j = 0; j < 8; ++j) v[j] = q ? vb[j] : va[j];
                if (part != nullptr && r >= PROMPT_ROWS) {
#pragma unroll
                    for (int pq = 0; pq < 4; ++pq) { const float* pr = part + ((size_t)pq * 2048 + (r - PROMPT_ROWS)) * DM;
#pragma unroll
                        for (int j = 0; j < 8; ++j) { const float4 a = *(const float4*)(pr + (j * 64 + lane) * 4); v[j].x += a.x; v[j].y += a.y; v[j].z += a.z; v[j].w += a.w; } }
                    if (xwb != nullptr) {
#pragma unroll
                        for (int j = 0; j < 8; ++j) *(float4*)(xwb + (size_t)r * DM + (j * 64 + lane) * 4) = v[j]; }
                }
                float ss = 0.f;
#pragma unroll
                for (int j = 0; j < 8; ++j) ss += v[j].x * v[j].x + v[j].y * v[j].y + v[j].z * v[j].z + v[j].w * v[j].w;
                ss = wave_sum(ss);
                const float rs = rsqrtf(ss * (1.f / DM) + 1e-6f);
#pragma unroll
                for (int j = 0; j < 8; ++j) { const int c = (j * 64 + lane) * 4;
                    if (FINAL) *(float4*)(yout + (size_t)r * DM + c) = make_float4(v[j].x * rs * gv[j].x, v[j].y * rs * gv[j].y, v[j].z * rs * gv[j].z, v[j].w * rs * gv[j].w);
                    else { u32x2 w; w[0] = cvt_pk_bf16(v[j].x * rs * gv[j].x, v[j].y * rs * gv[j].y); w[1] = cvt_pk_bf16(v[j].z * rs * gv[j].z, v[j].w * rs * gv[j].w);
                        *(u32x2*)(h + (size_t)r * DM + c) = w; } }
            }
        }
    }
}

__device__ __forceinline__ void phase_prep(const Params& p, int l, LAS unsigned char* lds) {
    unsigned char* ws = p.ws; LAS unsigned* tl = (LAS unsigned*)lds; int rot = 0;
    const float* win = p.in[I_WIN] + (size_t)l * DM * NIN;
    bf16_t* WIN = (bf16_t*)(ws + OFF_WIN);
    conv_job(win, NIN, DM, 0, 1536, WIN, DM, 0, tl, rot);
    conv_job(win, NIN, DM, 1552, 2048, WIN, DM, 1536, tl, rot);
    conv_job(win, NIN, DM, 3600, 2048, WIN, DM, 3584, tl, rot);
    conv_job(win, NIN, DM, 5656, 2048, WIN, DM, 5632, tl, rot);
    conv_job(win, NIN, DM, 1536, 16, WIN, DM, 7680, tl, rot);
    conv_job(win, NIN, DM, 5648, 8, WIN, DM, 7696, tl, rot);
    conv_job<1>(win, NIN, DM, 7704, 8192, (bf16_t*)(ws + OFF_WMG), DM, 0, tl, rot);
    for (int n = 0; n < 4; ++n) conv_job(p.in[I_WBR] + ((size_t)l * 4 + n) * 512 * DM, DM, 512, 0, DM, (bf16_t*)(ws + OFF_WBR) + (size_t)n * DM * 512, 512, 0, tl, rot);
    {
        u32x4* z = (u32x4*)(WIN + (size_t)7704 * DM); const int n16 = (NPROJ - 7704) * DM * 2 / 16;
        for (int i = blockIdx.x * 512 + threadIdx.x; i < n16; i += gridDim.x * 512) z[i] = (u32x4){0u, 0u, 0u, 0u};
    }
    if (l == 0) norm_rows2(p.in[I_XP], p.in[I_XS], p.in[I_NMG], (bf16_t*)(ws + OFF_H), nullptr, nullptr);
    else norm_rows2(p.out, p.out + O_YS, p.in[I_NMG] + DM, (bf16_t*)(ws + OFF_H), (const float*)(ws + OFF_BIG), p.out);
}

constexpr int LA_QT = 0, LA_KT = 17408, LA_KH = 34816, LA_VT = 53248, LA_ATT = 71680, LA_BB = 80896;
constexpr int LDQ = 136, LDT = 72, LDBB = 132;

struct LinRegs { u32x4 q0, q1, k0, k1, v0, v1, l0, l1; };
template <int MODE>
__device__ __forceinline__ void lin_load(const Params& p, int cgi, int h, int tid, LinRegs& R) {
    constexpr int K = (MODE == 0) ? 64 : 128, KPT = K / 8;
    constexpr int CQ = (MODE == 0) ? C_GLA_Q : (MODE == 1 ? C_HG_Q : C_RET_Q), CK = (MODE == 0) ? C_GLA_K : (MODE == 1 ? C_HG_F : C_RET_K),
                  CV = (MODE == 0) ? C_GLA_V : (MODE == 1 ? C_HG_I : C_RET_V);
    const int t = tid >> 3, sub = tid & 7, k0 = sub * KPT;
    const bf16_t* prow = (const bf16_t*)(p.ws + OFF_PROJ) + (size_t)(cgi * 64 + t) * NPROJ;
    const u32x4 z4 = {0u, 0u, 0u, 0u}; R.q0 = z4; R.q1 = z4; R.k0 = z4; R.k1 = z4; R.l0 = z4; R.l1 = z4;
    if (MODE == 0) { R.q0 = *(const u32x4*)(prow + CQ + h * 64 + k0); R.k0 = *(const u32x4*)(prow + CK + h * 64 + k0); R.l0 = *(const u32x4*)(prow + C_GLA_LR); R.l1 = *(const u32x4*)(prow + C_GLA_LR + 8); }
    if (MODE == 1) { R.q0 = *(const u32x4*)(prow + CQ + h * 128 + k0); R.q1 = *(const u32x4*)(prow + CQ + h * 128 + k0 + 8); R.k0 = *(const u32x4*)(prow + CK + h * 128 + k0); R.k1 = *(const u32x4*)(prow + CK + h * 128 + k0 + 8); }
    if (MODE == 2) { const int i0 = sub * 8; R.q0 = *(const u32x4*)(prow + CQ + h * 128 + i0); R.q1 = *(const u32x4*)(prow + CQ + h * 128 + 64 + i0); R.k0 = *(const u32x4*)(prow + CK + h * 128 + i0); R.k1 = *(const u32x4*)(prow + CK + h * 128 + 64 + i0); }
    R.v0 = *(const u32x4*)(prow + CV + h * 128 + sub * 16); R.v1 = *(const u32x4*)(prow + CV + h * 128 + sub * 16 + 8);
}
template <int MODE>
__device__ __forceinline__ void stepA_lin(const Params& p, int l, int cgi, int h, LAS unsigned char* lds, const LinRegs& R) {
    constexpr int K = (MODE == 0) ? 64 : 128, KPT = K / 8;
    int tid = threadIdx.x; asm volatile("" : "+v"(tid));
    const ChunkInfo ci = chunk_info(cgi); const int idx = cgi * 4 + h, t = tid >> 3, sub = tid & 7;
    bf16_t* proj = (bf16_t*)(p.ws + OFF_PROJ);
    LAS bf16_t* QT = (LAS bf16_t*)(lds + LA_QT); LAS bf16_t* KT = (LAS bf16_t*)(lds + LA_KT); LAS bf16_t* KH = (LAS bf16_t*)(lds + LA_KH);
    LAS bf16_t* VT = (LAS bf16_t*)(lds + LA_VT); LAS bf16_t* ATT = (LAS bf16_t*)(lds + LA_ATT); LAS float* BB = (LAS float*)(lds + LA_BB);
    bf16_t* prow = proj + (size_t)(ci.row0 + t) * NPROJ;
    constexpr int CQ = (MODE == 0) ? C_GLA_Q : (MODE == 1 ? C_HG_Q : C_RET_Q), CK = (MODE == 0) ? C_GLA_K : (MODE == 1 ? C_HG_F : C_RET_K),
                  CV = (MODE == 0) ? C_GLA_V : (MODE == 1 ? C_HG_I : C_RET_V);
    bf16_t* ST = (bf16_t*)(p.ws + (MODE == 0 ? OFF_ST_GLA : (MODE == 1 ? OFF_ST_HG : OFF_ST_RET))) + (size_t)idx * 128 * K;
    const int k0 = sub * KPT;
    const u32x4 rq0 = R.q0, rq1 = R.q1, rk0 = R.k0, rk1 = R.k1, rv0 = R.v0, rv1 = R.v1;
    float lbv[KPT];
    if (MODE == 1) {
#pragma unroll
        for (int j = 0; j < KPT; ++j) { if (l == 0) lbv[j] = 0.f; else { const float z0 = p.in[I_LB][h * 128 + k0 + j], z1 = p.in[I_LB][512 + h * 128 + k0 + j]; lbv[j] = sigm(z1 - z0); } }
    }
    if (MODE == 0) {
        const u32x4 l0 = R.l0, l1 = R.l1;
        float lr[16]; unpack8(l0, lr); unpack8(l1, lr + 8);
        const float* wgk = p.in[I_WGK] + (size_t)l * 16 * 256 + h * 64 + k0; const float* bgk = p.in[I_BGK] + l * 256 + h * 64 + k0;
        float gk[8];
#pragma unroll
        for (int j = 0; j < 8; ++j) gk[j] = bgk[j];
#pragma unroll
        for (int r = 0; r < 16; ++r) { const float4 w0 = *(const float4*)(wgk + r * 256), w1 = *(const float4*)(wgk + r * 256 + 4);
            gk[0] += lr[r] * w0.x; gk[1] += lr[r] * w0.y; gk[2] += lr[r] * w0.z; gk[3] += lr[r] * w0.w; gk[4] += lr[r] * w1.x; gk[5] += lr[r] * w1.y; gk[6] += lr[r] * w1.z; gk[7] += lr[r] * w1.w; }
#pragma unroll
        for (int j = 0; j < 8; ++j) BB[t * LDBB + k0 + j] = logsig(gk[j]) * (1.f / 16.f);
    } else if (MODE == 1) {
        float z[16]; unpack8(rk0, z); unpack8(rk1, z + 8);
#pragma unroll
        for (int j = 0; j < 16; ++j) { const float f = lbv[j] + (1.f - lbv[j]) * sigm(z[j]); BB[t * LDBB + k0 + j] = __logf(f); }
    }
    float lg2 = 0.f;
    if (MODE == 2) lg2 = __log2f(1.f - exp2f(-5.f - (float)h));
    if (MODE != 2) {
        lds_barrier();
        {
            LAS float* GT = (LAS float*)(lds + LA_ATT); const int kk_ = tid & (K - 1), g_ = tid / K; float pv[16];
            if (tid < 4 * K) { float run = 0.f;
#pragma unroll
                for (int i = 0; i < 16; ++i) { run += BB[(g_ * 16 + i) * LDBB + kk_]; pv[i] = run; }
                GT[g_ * K + kk_] = run; }
            lds_barrier();
            if (tid < 4 * K) { float off = 0.f;
#pragma unroll
                for (int g2 = 0; g2 < 3; ++g2) off += (g2 < g_) ? GT[g2 * K + kk_] : 0.f;
#pragma unroll
                for (int i = 0; i < 16; ++i) BB[(g_ * 16 + i) * LDBB + kk_] = pv[i] + off; }
        }
        lds_barrier();
    }
    {
        float q[KPT], kk[KPT];
        if (MODE == 0) {
            unpack8(rq0, q); unpack8(rk0, kk);
#pragma unroll
            for (int j = 0; j < 8; ++j) q[j] *= 0.125f;
        } else if (MODE == 1) {
            unpack8(rq0, q); unpack8(rq1, q + 8); unpack8(rk0, kk); unpack8(rk1, kk + 8);
#pragma unroll
            for (int j = 0; j < 16; ++j) { q[j] = silu(q[j]); const float f = lbv[j] + (1.f - lbv[j]) * sigm(kk[j]); kk[j] = 1.f - f; }
        }
        if (MODE != 2) {
            float qt[KPT], kt[KPT], qx[KPT];
#pragma unroll
            for (int j = 0; j < KPT; ++j) { const float b = BB[t * LDBB + k0 + j], bm = BB[31 * LDBB + k0 + j], be = BB[63 * LDBB + k0 + j];
                qt[j] = q[j] * expc(b - bm); kt[j] = kk[j] * expc(bm - b); qx[j] = q[j] * __expf(b);
                KH[swz64(k0 + j, t, LDT)] = f2bf(kk[j] * __expf(be - b));
                if (t == 63) ((float*)(p.ws + (MODE == 0 ? OFF_DEC_GLA : OFF_DEC_HG)))[(size_t)idx * K + k0 + j] = __expf(be); }
#pragma unroll
            for (int j = 0; j < KPT; j += 8) { *(LAS u32x4*)(QT + t * LDQ + k0 + j) = pack8(qt + j); *(LAS u32x4*)(KT + t * LDQ + k0 + j) = pack8(kt + j);
                *(u32x4*)(prow + CQ + h * K + k0 + j) = pack8(qx + j); }
        } else {
            const int i0 = sub * 8; const float pos = ci.pos0 + (float)t;
            float q1[8], q2[8], k1[8], k2[8];
            unpack8(rq0, q1); unpack8(rq1, q2); unpack8(rk0, k1); unpack8(rk1, k2);
            const float gq = exp2f(lg2 * (float)(t + 1)), gk_ = exp2f(lg2 * (float)(63 - t));
            float qa[8], qb[8], ka[8], kb[8], xa[8], xb[8];
#pragma unroll
            for (int j = 0; j < 8; ++j) {
                const float inv = exp2f(-(float)(i0 + j) * (13.287712379549449f / 64.f));
                const float ang = pos * inv;
                const float nrev = rintf(ang * 0.15915494309189535f);
                float rr = fmaf(-nrev, 6.2831854820251465f, ang); rr = fmaf(-nrev, -1.7484555e-7f, rr);
                const float cs = __cosf(rr), sn = __sinf(rr);
                qa[j] = q1[j] * cs - q2[j] * sn; qb[j] = q1[j] * sn + q2[j] * cs;
                const float ka_ = (k1[j] * cs - k2[j] * sn) * 0.08838834764831845f, kb_ = (k1[j] * sn + k2[j] * cs) * 0.08838834764831845f;
                ka[j] = ka_; kb[j] = kb_;
                KH[swz64(i0 + j, t, LDT)] = f2bf(ka_ * gk_); KH[swz64(64 + i0 + j, t, LDT)] = f2bf(kb_ * gk_);
                xa[j] = qa[j] * gq; xb[j] = qb[j] * gq;
            }
            *(LAS u32x4*)(QT + t * LDQ + i0) = pack8(qa); *(LAS u32x4*)(QT + t * LDQ + 64 + i0) = pack8(qb);
            *(LAS u32x4*)(KT + t * LDQ + i0) = pack8(ka); *(LAS u32x4*)(KT + t * LDQ + 64 + i0) = pack8(kb);
            *(u32x4*)(prow + CQ + h * 128 + i0) = pack8(xa); *(u32x4*)(prow + CQ + h * 128 + 64 + i0) = pack8(xb);
        }
        float v[16];
        unpack8(rv0, v); unpack8(rv1, v + 8);
#pragma unroll
        for (int j = 0; j < 16; ++j) VT[swz64(sub * 16 + j, t, LDT)] = f2bf(v[j]);
    }
    lds_barrier();
    lds_mm(QT, LDQ, KT, LDQ, 2, 2, K / 32, [&](int r, int c, f32x4 a) {
        float o[4];
#pragma unroll
        for (int j = 0; j < 4; ++j) { float x = a[j]; if (MODE == 2) x *= exp2f(lg2 * (float)(r - c - j)); o[j] = (c + j <= r) ? x : 0.f; }
        u32x2 w; w[0] = cvt_pk_bf16(o[0], o[1]); w[1] = cvt_pk_bf16(o[2], o[3]); *(LAS u32x2*)(ATT + r * LDT + c) = w; });
    {
        const float* sin_ = p.in[MODE == 0 ? I_SGLA : (MODE == 1 ? I_SHG : I_SRET)] + ((size_t)(l * 32 + ci.b) * 4 + h) * K * 128;
        float* sout = p.out + (MODE == 0 ? O_SGLA : (MODE == 1 ? O_SHG : O_SRET)) + ((size_t)(l * 32 + ci.b) * 4 + h) * K * 128;
        const float dret = exp2f(lg2 * 64.f);
        lds_mm<true, true>(VT, LDT, KH, LDT, 4, K / 32, 2, [&](int r, int c, f32x4 a) {
            u32x2 w;
            if (ci.sample) {
                float s0[4];
#pragma unroll
                for (int j = 0; j < 4; ++j) { s0[j] = sin_[(size_t)(c + j) * 128 + r]; const float d = (MODE == 2) ? dret : __expf(BB[63 * LDBB + c + j]); sout[(size_t)(c + j) * 128 + r] = d * s0[j] + a[j]; }
                w[0] = cvt_pk_bf16(s0[0], s0[1]); w[1] = cvt_pk_bf16(s0[2], s0[3]);
            } else { w[0] = cvt_pk_bf16(a[0], a[1]); w[1] = cvt_pk_bf16(a[2], a[3]); }
            *(u32x2*)(ST + (size_t)r * K + c) = w; });
    }
    lds_barrier();
    lds_mm<false, true>(ATT, LDT, VT, LDT, 2, 4, 2, [&](int r, int c, f32x4 a) {
        u32x2 w; w[0] = cvt_pk_bf16(a[0], a[1]); w[1] = cvt_pk_bf16(a[2], a[3]);
        *(u32x2*)(proj + (size_t)(ci.row0 + r) * NPROJ + CV + h * 128 + c) = w; });
    lds_barrier();
}

constexpr int LG_Q = 0, LG_K = 17408, LG_KT = 34816, LG_VT = 53248, LG_WT = 71680, LG_ATT = 90112, LG_MM = 99328, LG_SC = 116736;
constexpr int LDMM = 68;
__device__ __forceinline__ void stepA_gdn(const Params& p, int l, int cgi, int h, LAS unsigned char* lds) {
    int tid = threadIdx.x; asm volatile("" : "+v"(tid));
    const ChunkInfo ci = chunk_info(cgi); const int idx = cgi * 4 + h, t = tid >> 3, sub = tid & 7;
    const bf16_t* proj = (const bf16_t*)(p.ws + OFF_PROJ);
    LAS bf16_t* Q = (LAS bf16_t*)(lds + LG_Q); LAS bf16_t* KK = (LAS bf16_t*)(lds + LG_K); LAS bf16_t* KTr = (LAS bf16_t*)(lds + LG_KT);
    LAS bf16_t* VT = (LAS bf16_t*)(lds + LG_VT); LAS bf16_t* WT = (LAS bf16_t*)(lds + LG_WT); LAS bf16_t* ATT = (LAS bf16_t*)(lds + LG_ATT);
    LAS float* MM = (LAS float*)(lds + LG_MM); LAS float* SB = (LAS float*)(lds + LG_SC);
    const float* cw = p.in[I_GCW] + (size_t)l * 4 * 1536;
    const float* cache = p.in[I_CGDN] + (size_t)(l * 32 + ci.b) * 3 * 1536;
    float* cout = p.out + (ci.sample ? O_SGC + (size_t)(l * 32 + ci.b) * 3 * 1536 : O_PGC + (size_t)(l * 2 + ci.b) * 3 * 1536);
#pragma unroll
    for (int part = 0; part < 3; ++part) {
        const int ch0 = part * 512 + h * 128 + sub * 16;
        float acc[16];
#pragma unroll
        for (int c = 0; c < 16; ++c) acc[c] = 0.f;
#pragma unroll
        for (int j = 0; j < 4; ++j) {
            const int tr = t + j - 3; float x[16];
            if (tr >= 0 || !ci.first) { const bf16_t* sp = proj + (size_t)(ci.row0 + tr) * NPROJ + C_GDN_QKV + ch0; unpack8(*(const u32x4*)sp, x); unpack8(*(const u32x4*)(sp + 8), x + 8); }
            else if (ci.sample) { const float* sp = cache + (size_t)(t + j) * 1536 + ch0;
#pragma unroll
                for (int c = 0; c < 16; c += 4) { const float4 f = *(const float4*)(sp + c); x[c] = f.x; x[c + 1] = f.y; x[c + 2] = f.z; x[c + 3] = f.w; } }
            else {
#pragma unroll
                for (int c = 0; c < 16; ++c) x[c] = 0.f; }
            const float* wp = cw + j * 1536 + ch0;
#pragma unroll
            for (int c = 0; c < 16; c += 4) { const float4 w = *(const float4*)(wp + c); acc[c] += w.x * x[c]; acc[c + 1] += w.y * x[c + 1]; acc[c + 2] += w.z * x[c + 2]; acc[c + 3] += w.w * x[c + 3]; }
            if (j == 3 && ci.last && t >= 61) {
                float* op = cout + (size_t)(t - 61) * 1536 + ch0;
#pragma unroll
                for (int c = 0; c < 16; c += 4) *(float4*)(op + c) = make_float4(x[c], x[c + 1], x[c + 2], x[c + 3]); }
        }
        float ss = 0.f;
#pragma unroll
        for (int c = 0; c < 16; ++c) { acc[c] = silu(acc[c]); ss += acc[c] * acc[c]; }
        if (part < 2) {
            ss += __shfl_xor(ss, 1); ss += __shfl_xor(ss, 2); ss += __shfl_xor(ss, 4);
            const float rn = rsqrtf(ss + 1e-6f) * (part == 0 ? 0.08838834764831845f : 1.f);
#pragma unroll
            for (int c = 0; c < 16; ++c) acc[c] *= rn;
            LAS bf16_t* dst = (part == 0) ? Q : KK;
            *(LAS u32x4*)(dst + t * LDQ + sub * 16) = pack8(acc); *(LAS u32x4*)(dst + t * LDQ + sub * 16 + 8) = pack8(acc + 8);
            if (part == 1) {
#pragma unroll
                for (int c = 0; c < 16; ++c) KTr[(sub * 16 + c) * LDT + t] = f2bf(acc[c]); }
        } else {
#pragma unroll
            for (int c = 0; c < 16; ++c) VT[(sub * 16 + c) * LDT + t] = f2bf(acc[c]);
        }
    }
    if (tid < 64) {
        const bf16_t* pr = proj + (size_t)(ci.row0 + tid) * NPROJ;
        const float beta = sigm(bf2f(pr[C_GDN_B + h]));
        float g = -__expf(p.in[I_ALOG][l * 4 + h]) * softplus(bf2f(pr[C_GDN_A + h]) + p.in[I_DTB][l * 4 + h]);
#pragma unroll
        for (int o = 1; o < 64; o <<= 1) { const float n = __shfl_up(g, o); if (tid >= o) g += n; }
        SB[tid] = g; SB[64 + tid] = beta; SB[128 + tid] = beta * __expf(g);
    }
    lds_barrier();
    lds_mm(KK, LDQ, KK, LDQ, 2, 2, 4, [&](int r, int c, f32x4 a) {
        const float br = SB[r], be = SB[64 + r];
        f32x4 o;
#pragma unroll
        for (int j = 0; j < 4; ++j) o[j] = (c + j < r) ? be * a[j] * __expf(br - SB[c + j]) : 0.f;
        *(LAS f32x4*)(MM + r * LDMM + c) = o; });
    lds_mm(Q, LDQ, KK, LDQ, 2, 2, 4, [&](int r, int c, f32x4 a) {
        const float br = SB[r]; float o[4];
#pragma unroll
        for (int j = 0; j < 4; ++j) o[j] = (c + j <= r) ? a[j] * __expf(br - SB[c + j]) : 0.f;
        u32x2 w; w[0] = cvt_pk_bf16(o[0], o[1]); w[1] = cvt_pk_bf16(o[2], o[3]); *(LAS u32x2*)(ATT + r * LDT + c) = w; });
    lds_barrier();
    if (tid < 256) {
        const bool isk = tid < 128;
        LAS bf16_t* rowp = isk ? (KTr + tid * LDT) : (VT + (tid - 128) * LDT);
        LAS bf16_t* dstp = isk ? (WT + tid * LDT) : rowp;
        const LAS float* fac = isk ? (SB + 128) : (SB + 64);
#pragma unroll 1
        for (int b0 = 0; b0 < 64; b0 += 16) {
            float s[16];
            { float x[8]; unpack8(*(const LAS u32x4*)(rowp + b0), x);
#pragma unroll
              for (int j = 0; j < 8; ++j) s[j] = x[j] * fac[b0 + j];
              unpack8(*(const LAS u32x4*)(rowp + b0 + 8), x);
#pragma unroll
              for (int j = 0; j < 8; ++j) s[8 + j] = x[j] * fac[b0 + 8 + j]; }
#pragma unroll 1
            for (int jc = 0; jc < b0; jc += 8) {
                float w8[8]; unpack8(*(const LAS u32x4*)(dstp + jc), w8);
#pragma unroll
                for (int i = 0; i < 16; ++i) {
                    const f32x4 m0 = *(const LAS f32x4*)(MM + (b0 + i) * LDMM + jc), m1 = *(const LAS f32x4*)(MM + (b0 + i) * LDMM + jc + 4);
                    s[i] -= m0[0] * w8[0] + m0[1] * w8[1] + m0[2] * w8[2] + m0[3] * w8[3] + m1[0] * w8[4] + m1[1] * w8[5] + m1[2] * w8[6] + m1[3] * w8[7];
                }
            }
#pragma unroll
            for (int i = 1; i < 16; ++i) {
#pragma unroll
                for (int j = 0; j < i; ++j) s[i] -= MM[(b0 + i) * LDMM + b0 + j] * s[j];
            }
            *(LAS u32x4*)(dstp + b0) = pack8(s); *(LAS u32x4*)(dstp + b0 + 8) = pack8(s + 8);
        }
    }
    lds_barrier();
    {
        const int i = tid >> 2, s0 = (tid & 3) * 16; const float bend = SB[63];
        float x[16]; unpack8(*(const LAS u32x4*)(KTr + i * LDT + s0), x); unpack8(*(const LAS u32x4*)(KTr + i * LDT + s0 + 8), x + 8);
#pragma unroll
        for (int j = 0; j < 16; ++j) x[j] *= __expf(bend - SB[s0 + j]);
        *(LAS u32x4*)(KTr + i * LDT + s0) = pack8(x); *(LAS u32x4*)(KTr + i * LDT + s0 + 8) = pack8(x + 8);
    }
    bf16_t* GQX = (bf16_t*)(p.ws + OFF_GQX) + (size_t)idx * 64 * 128; bf16_t* GO0 = (bf16_t*)(p.ws + OFF_GO0) + (size_t)idx * 64 * 128;
    lds_mm(ATT, LDT, WT, LDT, 2, 4, 2, [&](int r, int c, f32x4 a) {
        const float eb = __expf(SB[r]); float o[4];
#pragma unroll
        for (int j = 0; j < 4; ++j) o[j] = bf2f(Q[r * LDQ + c + j]) * eb - a[j];
        u32x2 w; w[0] = cvt_pk_bf16(o[0], o[1]); w[1] = cvt_pk_bf16(o[2], o[3]); *(u32x2*)(GQX + r * 128 + c) = w; });
    lds_mm(ATT, LDT, VT, LDT, 2, 4, 2, [&](int r, int c, f32x4 a) {
        u32x2 w; w[0] = cvt_pk_bf16(a[0], a[1]); w[1] = cvt_pk_bf16(a[2], a[3]); *(u32x2*)(GO0 + r * 128 + c) = w; });
    lds_barrier();
    bf16_t* AG = (bf16_t*)(p.ws + OFF_A_GDN) + (size_t)idx * 128 * 128; bf16_t* BG = (bf16_t*)(p.ws + OFF_ST_GDN) + (size_t)idx * 128 * 128;
    const float ebe = __expf(SB[63]);
    lds_mm(KTr, LDT, WT, LDT, 4, 4, 2, [&](int r, int c, f32x4 a) {
        float o[4];
#pragma unroll
        for (int j = 0; j < 4; ++j) o[j] = ((r == c + j) ? ebe : 0.f) - a[j];
        u32x2 w; w[0] = cvt_pk_bf16(o[0], o[1]); w[1] = cvt_pk_bf16(o[2], o[3]); *(u32x2*)(AG + r * 128 + c) = w; });
    lds_mm(VT, LDT, KTr, LDT, 4, 4, 2, [&](int r, int c, f32x4 a) {
        u32x2 w; w[0] = cvt_pk_bf16(a[0], a[1]); w[1] = cvt_pk_bf16(a[2], a[3]); *(u32x2*)(BG + r * 128 + c) = w; });
    lds_barrier();
}

__device__ __forceinline__ void phase_stepA(const Params& p, int l, LAS unsigned char* lds) {
    const int G = gridDim.x; int it = blockIdx.x;
    for (; it < NITEM; it += G) stepA_gdn(p, l, it >> 2, it & 3, lds);
#define LIN_LOOP(MODE, BASE) { LinRegs R{}, N{}; const int tid_ = threadIdx.x; \
        if (it < (BASE) + NITEM) { const int j = it - (BASE); lin_load<MODE>(p, j >> 2, j & 3, tid_, R); } \
        for (; it < (BASE) + NITEM; it += G) { const int j = it - (BASE), jn = j + G; N = R; \
            if (it + G < (BASE) + NITEM) lin_load<MODE>(p, jn >> 2, jn & 3, tid_, N);        \
            stepA_lin<MODE>(p, l, j >> 2, j & 3, lds, R); R = N; } }
    LIN_LOOP(1, NITEM)
    LIN_LOOP(2, 2 * NITEM)
    LIN_LOOP(0, 3 * NITEM)
#undef LIN_LOOP
}

__device__ __forceinline__ void gdn_chain(const Params& p, int cg0, int nsteps, int h, int vs, const float* sin_, float* sout, LAS unsigned char* lds) {
    const int tid = threadIdx.x, wid = tid >> 6, lane = tid & 63, fr = lane & 15, fq = lane >> 4, i0 = wid * 16;
    constexpr int NS = 33, SLOT = 16 * LDQ;
    LAS bf16_t* XS = (LAS bf16_t*)lds;
    const bf16_t* AG = (const bf16_t*)(p.ws + OFF_A_GDN); bf16_t* SG = (bf16_t*)(p.ws + OFF_ST_GDN);
    constexpr int PD = 8, UNR = 32;
    bf16x8 af[PD][4]; u32x2 bt[PD];
#pragma unroll
    for (int u = 0; u < PD; ++u) {
        if (u < nsteps) { const size_t idx = (size_t)(cg0 + u) * 4 + h;
#pragma unroll
            for (int ks = 0; ks < 4; ++ks) af[u][ks] = *(const bf16x8*)(AG + (idx * 128 + i0 + fr) * 128 + ks * 32 + fq * 8);
            bt[u] = *(const u32x2*)(SG + (idx * 128 + vs * 16 + fr) * 128 + i0 + fq * 4); }
    }
    f32x4 cur = {0.f, 0.f, 0.f, 0.f};
    {
        const int k = tid >> 2, v4 = (tid & 3) * 4;
        float4 s = make_float4(0.f, 0.f, 0.f, 0.f);
        if (sin_) s = *(const float4*)(sin_ + (size_t)k * 128 + vs * 16 + v4);
        if (sin_) {
#pragma unroll
            for (int j = 0; j < 4; ++j) cur[j] = sin_[(size_t)(i0 + fq * 4 + j) * 128 + vs * 16 + fr]; }
        XS[(v4 + 0) * LDQ + k] = f2bf(s.x); XS[(v4 + 1) * LDQ + k] = f2bf(s.y); XS[(v4 + 2) * LDQ + k] = f2bf(s.z); XS[(v4 + 3) * LDQ + k] = f2bf(s.w);
    }
    lds_barrier();
    for (int c0 = 0; c0 < nsteps; c0 += UNR) {
        const int sb = c0 % NS;
#pragma unroll
        for (int uu = 0; uu < UNR; ++uu) {
            const int u = uu & (PD - 1), c = c0 + uu;
            if (c < nsteps) {
                int sr = sb + uu; sr = sr >= NS ? sr - NS : sr; int sw = sr + 1; sw = sw >= NS ? sw - NS : sw;
                f32x4 acc = {bflo(bt[u][0]), bfhi(bt[u][0]), bflo(bt[u][1]), bfhi(bt[u][1])};
                const LAS bf16_t* xs = XS + sr * SLOT + fr * LDQ + fq * 8;
                {
                    f32x4 acc2 = {0.f, 0.f, 0.f, 0.f};
                    const bf16x8 x0 = *(const LAS bf16x8*)(xs), x1 = *(const LAS bf16x8*)(xs + 32), x2 = *(const LAS bf16x8*)(xs + 64), x3 = *(const LAS bf16x8*)(xs + 96);
                    acc = __builtin_amdgcn_mfma_f32_16x16x32_bf16(af[u][0], x0, acc, 0, 0, 0); acc2 = __builtin_amdgcn_mfma_f32_16x16x32_bf16(af[u][1], x1, acc2, 0, 0, 0);
                    acc = __builtin_amdgcn_mfma_f32_16x16x32_bf16(af[u][2], x2, acc, 0, 0, 0); acc2 = __builtin_amdgcn_mfma_f32_16x16x32_bf16(af[u][3], x3, acc2, 0, 0, 0);
                    acc += acc2;
                }
                cur = acc;
                { u32x2 w; w[0] = cvt_pk_bf16(cur[0], cur[1]); w[1] = cvt_pk_bf16(cur[2], cur[3]); *(LAS u32x2*)(XS + sw * SLOT + fr * LDQ + i0 + fq * 4) = w; }
                if (c + PD < nsteps) { const size_t idn = (size_t)(cg0 + c + PD) * 4 + h;
#pragma unroll
                    for (int ks = 0; ks < 4; ++ks) af[u][ks] = *(const bf16x8*)(AG + (idn * 128 + i0 + fr) * 128 + ks * 32 + fq * 8);
                    bt[u] = *(const u32x2*)(SG + (idn * 128 + vs * 16 + fr) * 128 + i0 + fq * 4); }
                lds_barrier();
            }
        }
        const int nb = min(UNR, nsteps - c0), piece = tid & 255, prow = piece >> 4, pc8 = (piece & 15) * 8;
        for (int uu = tid >> 8; uu < nb; uu += 2) {
            int sr = sb + uu; sr = sr >= NS ? sr - NS : sr;
            const u32x4 v = *(const LAS u32x4*)(XS + sr * SLOT + prow * LDQ + pc8);
            *(u32x4*)(SG + (((size_t)(cg0 + c0 + uu) * 4 + h) * 128 + vs * 16 + prow) * 128 + pc8) = v;
        }
        lds_barrier();
    }
#pragma unroll
    for (int j = 0; j < 4; ++j) sout[(size_t)(i0 + fq * 4 + j) * 128 + vs * 16 + fr] = cur[j];
    lds_barrier();
}

template <int K, int HASD>
__device__ __forceinline__ void lin_chain(bf16_t* ST, const float* DEC, float dconst, int s, int h, int v, int kg, float* pout) {
    float S[8];
#pragma unroll
    for (int j = 0; j < 8; ++j) S[j] = 0.f;
    for (int c0 = 0; c0 < 128; c0 += 8) {
        u32x4 U[8]; float4 D0[8], D1[8];
#pragma unroll
        for (int u = 0; u < 8; ++u) { const size_t idx = (size_t)(s * 128 + c0 + u) * 4 + h;
            U[u] = *(const u32x4*)(ST + (idx * 128 + v) * K + kg * 8);
            if (HASD) { D0[u] = *(const float4*)(DEC + idx * K + kg * 8); D1[u] = *(const float4*)(DEC + idx * K + kg * 8 + 4); } }
#pragma unroll
        for (int u = 0; u < 8; ++u) { const size_t idx = (size_t)(s * 128 + c0 + u) * 4 + h;
            *(u32x4*)(ST + (idx * 128 + v) * K + kg * 8) = pack8(S);
            float uf[8]; unpack8(U[u], uf);
            if (HASD) { S[0] = D0[u].x * S[0] + uf[0]; S[1] = D0[u].y * S[1] + uf[1]; S[2] = D0[u].z * S[2] + uf[2]; S[3] = D0[u].w * S[3] + uf[3];
                        S[4] = D1[u].x * S[4] + uf[4]; S[5] = D1[u].y * S[5] + uf[5]; S[6] = D1[u].z * S[6] + uf[6]; S[7] = D1[u].w * S[7] + uf[7]; }
            else {
#pragma unroll
                for (int j = 0; j < 8; ++j) S[j] = dconst * S[j] + uf[j]; } }
    }
#pragma unroll
    for (int j = 0; j < 8; ++j) pout[(size_t)(kg * 8 + j) * 128 + v] = S[j];
}

__device__ __forceinline__ void late_weights(const Params& p, int l, LAS unsigned char* lds) {
    unsigned char* ws = p.ws; LAS unsigned* tl = (LAS unsigned*)lds; int rot = 0; const int first = 64, cnt = (int)gridDim.x - 64;
    lds_barrier();
    conv_job(p.in[I_WOUT] + (size_t)l * DM * DM, DM, DM, 0, DM, (bf16_t*)(ws + OFF_WOUT), DM, 0, tl, rot, first, cnt);
    conv_job<2>(p.in[I_WFI] + (size_t)l * DM * NFI, NFI, DM, 0, NFI, (bf16_t*)(ws + OFF_WFI), DM, 0, tl, rot, first, cnt);
    conv_job(p.in[I_WFO] + (size_t)l * DFF * DM, DM, DFF, 0, DM, (bf16_t*)(ws + OFF_WFO), DFF, 0, tl, rot, first, cnt);
}
__device__ __forceinline__ void phase_scan(const Params& p, int l, LAS unsigned char* lds) {
    const int bid = blockIdx.x, G = gridDim.x;
    if (bid < 64) {
        const int chain = bid >> 3, vs = bid & 7, s = chain >> 2, h = chain & 3;
        gdn_chain(p, s * 128, 128, h, vs, nullptr, p.out + O_PGDN + ((size_t)(l * 2 + s) * 4 + h) * 128 * 128, lds);
        return;
    }
    for (int j = bid - 64; j < 1024; j += G - 64) {
        const int b = j >> 5, h = (j >> 3) & 3, vs = j & 7;
        gdn_chain(p, 256 + b, 1, h, vs, p.in[I_SGDN] + ((size_t)(l * 32 + b) * 4 + h) * 128 * 128, p.out + O_SGDN + ((size_t)(l * 32 + b) * 4 + h) * 128 * 128, lds);
    }
    for (int e = (bid - 64) * 512 + (int)threadIdx.x; e < 40960; e += (G - 64) * 512) {
        const int sh = e / 5120, r = e - sh * 5120, s = sh >> 2, h = sh & 3;
        if (r < 1024) lin_chain<64, 1>((bf16_t*)(p.ws + OFF_ST_GLA), (const float*)(p.ws + OFF_DEC_GLA), 0.f, s, h, r >> 3, r & 7, p.out + O_PGLA + ((size_t)(l * 2 + s) * 4 + h) * 64 * 128);
        else if (r < 3072) { const int q = r - 1024; lin_chain<128, 1>((bf16_t*)(p.ws + OFF_ST_HG), (const float*)(p.ws + OFF_DEC_HG), 0.f, s, h, q >> 4, q & 15, p.out + O_PHG + ((size_t)(l * 2 + s) * 4 + h) * 128 * 128); }
        else { const int q = r - 3072; const float d = exp2f(64.f * __log2f(1.f - exp2f(-5.f - (float)h)));
            lin_chain<128, 0>((bf16_t*)(p.ws + OFF_ST_RET), nullptr, d, s, h, q >> 4, q & 15, p.out + O_PRET + ((size_t)(l * 2 + s) * 4 + h) * 128 * 128); }
    }
    late_weights(p, l, lds);
}

constexpr int LC_QX = 0, LC_SX = 17408, LC_O = 52224;
struct StepCItem { const bf16_t* qsrc; const bf16_t* osrc; const bf16_t* st; const bf16_t* gp; const float* ng; const float* nb; bf16_t* op; int ldq, ldo, K, br; };
struct StepCRegs { u32x4 s[4]; u32x4 q[2]; u32x2 o[4]; u32x4 g[2]; };
__device__ __forceinline__ StepCItem stepC_item(const Params& p, int l, int it, int t, int sub) {
    StepCItem I; const bf16_t* proj = (const bf16_t*)(p.ws + OFF_PROJ);
    const int br = it & 3, j = it >> 2, cgi = j >> 2, h = j & 3, idx = j, row0 = cgi * 64;
    int gcol; I.br = br; I.K = (br == 0) ? 64 : 128; I.nb = nullptr;
    if (br == 0) { I.qsrc = proj + (size_t)row0 * NPROJ + C_GLA_Q + h * 64; I.ldq = NPROJ; I.osrc = proj + (size_t)row0 * NPROJ + C_GLA_V + h * 128; I.ldo = NPROJ;
        I.st = (const bf16_t*)(p.ws + OFF_ST_GLA) + (size_t)idx * 128 * 64; gcol = C_GLA_G; I.ng = p.in[I_GLANG] + l * 128; }
    else if (br == 1) { I.qsrc = proj + (size_t)row0 * NPROJ + C_HG_Q + h * 128; I.ldq = NPROJ; I.osrc = proj + (size_t)row0 * NPROJ + C_HG_I + h * 128; I.ldo = NPROJ;
        I.st = (const bf16_t*)(p.ws + OFF_ST_HG) + (size_t)idx * 128 * 128; gcol = C_HG_G; I.ng = p.in[I_HGNG] + l * 128; }
    else if (br == 2) { I.qsrc = (const bf16_t*)(p.ws + OFF_GQX) + (size_t)idx * 64 * 128; I.ldq = 128; I.osrc = (const bf16_t*)(p.ws + OFF_GO0) + (size_t)idx * 64 * 128; I.ldo = 128;
        I.st = (const bf16_t*)(p.ws + OFF_ST_GDN) + (size_t)idx * 128 * 128; gcol = C_GDN_Z; I.ng = p.in[I_GDNNG] + l * 128; }
    else { I.qsrc = proj + (size_t)row0 * NPROJ + C_RET_Q + h * 128; I.ldq = NPROJ; I.osrc = proj + (size_t)row0 * NPROJ + C_RET_V + h * 128; I.ldo = NPROJ;
        I.st = (const bf16_t*)(p.ws + OFF_ST_RET) + (size_t)idx * 128 * 128; gcol = C_RET_G; I.ng = p.in[I_RETNG] + l * 128; I.nb = p.in[I_RETNB] + l * 128; }
    I.gp = proj + (size_t)(row0 + t) * NPROJ + gcol + h * 128 + sub * 16;
    I.op = (bf16_t*)(p.ws + OFF_OCAT) + (size_t)(row0 + t) * DM + br * 512 + h * 128 + sub * 16;
    return I;
}
__device__ __forceinline__ void stepC_load(const StepCItem& I, StepCRegs& R, int tid, int t, int sub, int r, int c0) {
    const int kpr = I.K / 8, npc = 128 * kpr;
#pragma unroll
    for (int i = 0; i < 4; ++i) { const int pc = tid + i * 512; if (pc < npc) { const int v = pc / kpr, kq = pc - v * kpr; R.s[i] = *(const u32x4*)(I.st + (size_t)v * I.K + kq * 8); } }
    if (sub * 16 < I.K) { const bf16_t* sp = I.qsrc + (size_t)t * I.ldq + sub * 16; R.q[0] = *(const u32x4*)sp; R.q[1] = *(const u32x4*)(sp + 8); }
    R.o[0] = *(const u32x2*)(I.osrc + (size_t)r * I.ldo + c0); R.o[1] = *(const u32x2*)(I.osrc + (size_t)r * I.ldo + c0 + 16);
    R.o[2] = *(const u32x2*)(I.osrc + (size_t)(r + 16) * I.ldo + c0); R.o[3] = *(const u32x2*)(I.osrc + (size_t)(r + 16) * I.ldo + c0 + 16);
    R.g[0] = *(const u32x4*)I.gp; R.g[1] = *(const u32x4*)(I.gp + 8);
}
__device__ __forceinline__ void phase_stepC(const Params& p, int l, LAS unsigned char* lds) {
    const int tid = threadIdx.x, t = tid >> 3, sub = tid & 7;
    LAS bf16_t* QX = (LAS bf16_t*)(lds + LC_QX); LAS bf16_t* SX = (LAS bf16_t*)(lds + LC_SX); LAS float* OB = (LAS float*)(lds + LC_O);
    const int wid = tid >> 6, lane = tid & 63, fr = lane & 15, fq = lane >> 4, r = (wid >> 2) * 32 + fr, c0 = (wid & 3) * 32 + fq * 4;
    int it = blockIdx.x;
    if (it >= 4 * NITEM) return;
    StepCItem I = stepC_item(p, l, it, t, sub); StepCRegs R;
    stepC_load(I, R, tid, t, sub, r, c0);
    for (; it < 4 * NITEM; it += gridDim.x) {
        { const int kpr = I.K / 8, npc = 128 * kpr;
#pragma unroll
          for (int i = 0; i < 4; ++i) { const int pc = tid + i * 512; if (pc < npc) { const int v = pc / kpr, kq = pc - v * kpr; *(LAS u32x4*)(SX + v * LDQ + kq * 8) = R.s[i]; } }
          if (sub * 16 < I.K) { *(LAS u32x4*)(QX + t * LDQ + sub * 16) = R.q[0]; *(LAS u32x4*)(QX + t * LDQ + sub * 16 + 8) = R.q[1]; } }
        const u32x2 o00 = R.o[0], o01 = R.o[1], o10 = R.o[2], o11 = R.o[3]; const u32x4 g0 = R.g[0], g1 = R.g[1];
        const StepCItem C = I;
        lds_barrier();
        const int itn = it + gridDim.x;
        if (itn < 4 * NITEM) { I = stepC_item(p, l, itn, t, sub); stepC_load(I, R, tid, t, sub, r, c0); }
        {
            f32x4 a00 = {0.f, 0.f, 0.f, 0.f}, a01 = a00, a10 = a00, a11 = a00;
            const LAS bf16_t* xp = QX + r * LDQ + fq * 8; const LAS bf16_t* yp = SX + ((wid & 3) * 32 + fr) * LDQ + fq * 8;
            for (int k = 0; k < C.K / 32; ++k) {
                const bf16x8 x0 = *(const LAS bf16x8*)(xp + k * 32), x1 = *(const LAS bf16x8*)(xp + 16 * LDQ + k * 32);
                const bf16x8 y0 = *(const LAS bf16x8*)(yp + k * 32), y1 = *(const LAS bf16x8*)(yp + 16 * LDQ + k * 32);
                a00 = __builtin_amdgcn_mfma_f32_16x16x32_bf16(y0, x0, a00, 0, 0, 0); a01 = __builtin_amdgcn_mfma_f32_16x16x32_bf16(y1, x0, a01, 0, 0, 0);
                a10 = __builtin_amdgcn_mfma_f32_16x16x32_bf16(y0, x1, a10, 0, 0, 0); a11 = __builtin_amdgcn_mfma_f32_16x16x32_bf16(y1, x1, a11, 0, 0, 0);
            }
            *(LAS f32x4*)(OB + r * LDBB + c0) = (f32x4){a00[0] + bflo(o00[0]), a00[1] + bfhi(o00[0]), a00[2] + bflo(o00[1]), a00[3] + bfhi(o00[1])};
            *(LAS f32x4*)(OB + r * LDBB + c0 + 16) = (f32x4){a01[0] + bflo(o01[0]), a01[1] + bfhi(o01[0]), a01[2] + bflo(o01[1]), a01[3] + bfhi(o01[1])};
            *(LAS f32x4*)(OB + (r + 16) * LDBB + c0) = (f32x4){a10[0] + bflo(o10[0]), a10[1] + bfhi(o10[0]), a10[2] + bflo(o10[1]), a10[3] + bfhi(o10[1])};
            *(LAS f32x4*)(OB + (r + 16) * LDBB + c0 + 16) = (f32x4){a11[0] + bflo(o11[0]), a11[1] + bfhi(o11[0]), a11[2] + bflo(o11[1]), a11[3] + bfhi(o11[1])};
        }
        lds_barrier();
        {
            float o[16]; float s1 = 0.f, s2 = 0.f;
#pragma unroll
            for (int c = 0; c < 16; c += 4) { const f32x4 v = *(const LAS f32x4*)(OB + t * LDBB + sub * 16 + c); o[c] = v[0]; o[c + 1] = v[1]; o[c + 2] = v[2]; o[c + 3] = v[3]; }
#pragma unroll
            for (int c = 0; c < 16; ++c) { s1 += o[c]; s2 += o[c] * o[c]; }
            s1 += __shfl_xor(s1, 1); s1 += __shfl_xor(s1, 2); s1 += __shfl_xor(s1, 4);
            s2 += __shfl_xor(s2, 1); s2 += __shfl_xor(s2, 2); s2 += __shfl_xor(s2, 4);
            float mu = 0.f, rs;
            if (C.br == 3) { mu = s1 * (1.f / 128.f); const float var = fmaxf(s2 * (1.f / 128.f) - mu * mu, 0.f); rs = rsqrtf(var + 1e-6f); }
            else rs = rsqrtf(s2 * (1.f / 128.f) + 1e-6f);
            float gt[16]; unpack8(g0, gt); unpack8(g1, gt + 8);
            float y[16];
#pragma unroll
            for (int c = 0; c < 16; ++c) { float v = (o[c] - mu) * rs * C.ng[sub * 16 + c]; if (C.br == 3) v += C.nb[sub * 16 + c]; y[c] = v * silu(gt[c]); }
            *(u32x4*)C.op = pack8(y); *(u32x4*)(C.op + 8) = pack8(y + 8);
        }
        lds_barrier();
    }
}

__device__ __forceinline__ void phase_ffn_fix(const Params& p, int l) {
    const bf16_t* halo = (const bf16_t*)(p.ws + OFF_HALO); bf16_t* act = (bf16_t*)(p.ws + OFF_ACT);
    const float* cw = p.in[I_FCW] + (size_t)l * 3 * DFF; const float* cb = p.in[I_FCB] + (size_t)l * DFF;
    const bool split = (gridDim.x == 256);
    for (int w = blockIdx.x * 512 + threadIdx.x; w < NCHUNK * 688; w += gridDim.x * 512) {
        const int cgi = w / 688, j0 = (w - cgi * 688) * 8;
        if (split && cgi >= pg8::FFN_SPLIT_PM0 * 4 && j0 >= pg8::FFN_SPLIT_PN * 128) continue;
        const ChunkInfo ci = chunk_info(cgi);
        float a0[8], a1[8], u0[8], u1[8], h1[8], h2[8], y0[8], y1[8];
        const bf16_t* hc = halo + (size_t)cgi * 8 * DFF + j0;
        unpack8(*(const u32x4*)hc, a0); unpack8(*(const u32x4*)(hc + DFF), u0); unpack8(*(const u32x4*)(hc + 2 * DFF), a1); unpack8(*(const u32x4*)(hc + 3 * DFF), u1);
        if (!ci.first) { const bf16_t* hp = halo + (size_t)(cgi - 1) * 8 * DFF + j0; unpack8(*(const u32x4*)(hp + 4 * DFF), h2); unpack8(*(const u32x4*)(hp + 6 * DFF), h1); }
        else if (ci.sample) { const float* cp = p.in[I_CFFN] + (size_t)(l * 32 + ci.b) * 2 * DFF + j0;
#pragma unroll
            for (int c = 0; c < 8; ++c) { h2[c] = cp[c]; h1[c] = cp[DFF + c]; } }
        else {
#pragma unroll
            for (int c = 0; c < 8; ++c) { h1[c] = 0.f; h2[c] = 0.f; } }
#pragma unroll
        for (int c = 0; c < 8; ++c) { const float k0 = cw[j0 + c], k1 = cw[DFF + j0 + c], k2 = cw[2 * DFF + j0 + c], b = cb[j0 + c];
            y0[c] = silu(k0 * h2[c] + k1 * h1[c] + k2 * a0[c] + b) * u0[c]; y1[c] = silu(k0 * h1[c] + k1 * a0[c] + k2 * a1[c] + b) * u1[c]; }
        *(u32x4*)(act + (size_t)ci.row0 * DFF + j0) = pack8(y0); *(u32x4*)(act + (size_t)(ci.row0 + 1) * DFF + j0) = pack8(y1);
        if (ci.last) { float* co = p.out + (ci.sample ? O_SFC + (size_t)(l * 32 + ci.b) * 2 * DFF : O_PFC + (size_t)(l * 2 + ci.b) * 2 * DFF) + j0;
            float e0[8], e1[8]; unpack8(*(const u32x4*)(hc + 4 * DFF), e0); unpack8(*(const u32x4*)(hc + 6 * DFF), e1);
            *(float4*)co = make_float4(e0[0], e0[1], e0[2], e0[3]); *(float4*)(co + 4) = make_float4(e0[4], e0[5], e0[6], e0[7]);
            *(float4*)(co + DFF) = make_float4(e1[0], e1[1], e1[2], e1[3]); *(float4*)(co + DFF + 4) = make_float4(e1[4], e1[5], e1[6], e1[7]); }
    }
    if (split) {
        const float* pf = (const float*)(p.ws + OFF_PARTF);
        constexpr int CH0 = pg8::FFN_SPLIT_PM0 * 4, JC0 = pg8::FFN_SPLIT_PN * 128;
        for (int w = blockIdx.x * 512 + threadIdx.x; w < (NCHUNK - CH0) * 4 * 128; w += gridDim.x * 512) {
            const int c = w & 127, qq = (w >> 7) & 3, cgi = CH0 + (w >> 9), j = JC0 + c;
            const ChunkInfo ci = chunk_info(cgi);
            const float k0 = cw[j], k1 = cw[DFF + j], k2 = cw[2 * DFF + j], bb = cb[j];
            auto gate_at = [&](int row) -> float {
                const float* q = pf + ((size_t)((row >> 8) - pg8::FFN_SPLIT_PM0) * 65536) + (size_t)(row & 255) * 256 + c;
                return q[0] + q[(size_t)24 * 65536] + q[(size_t)48 * 65536] + q[(size_t)72 * 65536]; };
            auto up_at = [&](int row) -> float {
                const float* q = pf + ((size_t)((row >> 8) - pg8::FFN_SPLIT_PM0) * 65536) + (size_t)(row & 255) * 256 + 128 + c;
                return q[0] + q[(size_t)24 * 65536] + q[(size_t)48 * 65536] + q[(size_t)72 * 65536]; };
            const int t0 = qq * 16, r0 = ci.row0 + t0;
            float h1, h2;
            if (t0 > 0 || (!ci.first && cgi > CH0)) { h1 = gate_at(r0 - 1); h2 = gate_at(r0 - 2); }
            else if (!ci.first) { const bf16_t* hp = halo + (size_t)(cgi - 1) * 8 * DFF + j; h2 = bf2f(hp[4 * DFF]); h1 = bf2f(hp[6 * DFF]); }
            else if (ci.sample) { const float* cp = p.in[I_CFFN] + (size_t)(l * 32 + ci.b) * 2 * DFF + j; h2 = cp[0]; h1 = cp[DFF]; }
            else { h1 = 0.f; h2 = 0.f; }
            float* co = p.out + (ci.sample ? O_SFC + (size_t)(l * 32 + ci.b) * 2 * DFF : O_PFC + (size_t)(l * 2 + ci.b) * 2 * DFF) + j;
#pragma unroll 4
            for (int t = 0; t < 16; ++t) {
                const int row = r0 + t; const float a = gate_at(row), uu = up_at(row);
                act[(size_t)row * DFF + j] = f2bf(silu(k0 * h2 + k1 * h1 + k2 * a + bb) * uu);
                if (ci.last && t0 + t >= 62) co[(size_t)(t0 + t - 62) * DFF] = a;
                h2 = h1; h1 = a;
            }
        }
    }
}

#define XB_TMO      128
#define XB_XCNT(j)  (256  + 64 * (j))
#define XB_XSUB(j)  (1280 + 64 * (j))
#define XB_XGEN(j)  (2304 + 64 * (j))
#define XB_TOP      3328
#define XB_TOPGEN   3392
#define XCD_BAR_WORDS 3456
#define XB_SPIN_CAP (1u << 23)
__device__ __forceinline__ unsigned xb_ld(unsigned* p)              { return __hip_atomic_load(p, __ATOMIC_RELAXED, __HIP_MEMORY_SCOPE_AGENT); }
__device__ __forceinline__ unsigned xb_add(unsigned* p, unsigned v) { return __hip_atomic_fetch_add(p, v, __ATOMIC_RELAXED, __HIP_MEMORY_SCOPE_AGENT); }
__device__ __forceinline__ unsigned xb_xcc_id() { return (unsigned)__builtin_amdgcn_s_getreg((3 << 11) | 20) & 0xFu; }
#define XB_SPIN(cond, bar) do { unsigned _sp = 0; while (cond) { __builtin_amdgcn_s_sleep(1); \
    if ((++_sp & 255u) == 0u) { if (xb_ld(&(bar)[XB_TMO])) break; if (_sp > XB_SPIN_CAP) { atomicAdd(&(bar)[XB_TMO], 1u); break; } } } } while (0)
struct XcdBarrier { unsigned* bar; unsigned x; volatile LAS unsigned* st; };
__device__ __forceinline__ XcdBarrier xcd_barrier_post(unsigned* bar, volatile LAS unsigned* st) {
    XcdBarrier b; b.bar = bar; b.x = xb_xcc_id(); b.st = st;
    if (threadIdx.x == 0) (void)xb_add(&bar[XB_XCNT(b.x)], 1u);
    return b;
}
__device__ __forceinline__ void xcd_barrier_complete(unsigned* bar, unsigned x, unsigned& nloc, unsigned& nx) {
    const unsigned G = gridDim.x * gridDim.y * gridDim.z;
    unsigned sum, cnt, mine, sp = 0u;
    for (;;) {
        sum = 0u; cnt = 0u; mine = 0u;
#pragma unroll
        for (unsigned j = 0; j < 16; ++j) { const unsigned c = xb_ld(&bar[XB_XCNT(j)]); sum += c; cnt += (c > 0u) ? 1u : 0u; mine = (j == x) ? c : mine; }
        if (sum == G) break;
        __builtin_amdgcn_s_sleep(1);
        if ((++sp & 255u) == 0u) { if (xb_ld(&bar[XB_TMO])) break; if (sp > XB_SPIN_CAP) { atomicAdd(&bar[XB_TMO], 1u); break; } }
    }
    nloc = mine > 0u ? mine : 1u; nx = cnt > 0u ? cnt : 1u;
}
__device__ __forceinline__ void xcd_barrier(const XcdBarrier& b) {
    asm volatile("s_waitcnt vmcnt(0)" ::: "memory");
    __syncthreads();
    if (threadIdx.x == 0) {
        unsigned* bar = b.bar;
        __builtin_amdgcn_s_waitcnt(0);
        unsigned nloc = b.st[0], nx = b.st[1];
        if (nloc == 0u) { xcd_barrier_complete(bar, b.x, nloc, nx); b.st[0] = nloc; b.st[1] = nx; }
        const unsigned old = xb_add(&bar[XB_XSUB(b.x)], 1u);
        const unsigned gen = old / nloc;
        if (old + 1u == (gen + 1u) * nloc) {
            __builtin_amdgcn_fence(__ATOMIC_RELEASE, "agent");
            asm volatile("s_waitcnt vmcnt(0)" ::: "memory");
            const unsigned og = xb_add(&bar[XB_TOP], 1u);
            const unsigned tg = og / nx;
            if (og + 1u == (tg + 1u) * nx) xb_add(&bar[XB_TOPGEN], 1u);
            else XB_SPIN(xb_ld(&bar[XB_TOPGEN]) == tg, bar);
            __builtin_amdgcn_fence(__ATOMIC_ACQUIRE, "agent");
            xb_add(&bar[XB_XGEN(b.x)], 1u);
            asm volatile("s_waitcnt vmcnt(0)" ::: "memory");
        } else {
            XB_SPIN(xb_ld(&bar[XB_XGEN(b.x)]) == gen, bar);
            __builtin_amdgcn_fence(__ATOMIC_ACQUIRE, "agent");
            asm volatile("s_waitcnt vmcnt(0)" ::: "memory");
        }
    }
    __syncthreads();
}

constexpr int PH_PER_LAYER = 12, N_PHASES = 2 * PH_PER_LAYER + 1;


template <int PH>
__device__ __forceinline__ void run_phase(const Params& p, LAS unsigned char* lds) {
    unsigned char* ws = p.ws; const int G = gridDim.x, c = blockIdx.x;
    constexpr int l = PH / PH_PER_LAYER, q = PH - l * PH_PER_LAYER;
    if constexpr (PH == 2 * PH_PER_LAYER) { norm_rows2<true>(p.out, p.out + O_YS, p.in[I_NFIN], nullptr, (const float*)(ws + OFF_BIG), nullptr, p.out); }
    else if constexpr (q == 0) phase_prep(p, l, lds);
    else if constexpr (q == 1) { pg8::TileOrder S{(const char*)(ws + OFF_H), (const char*)(ws + OFF_WIN), DM, DM, M_TOK / 256, NPROJ / 256, G, c, DM / 64};
              pg8::EpiBf16<0> E{(bf16_t*)(ws + OFF_PROJ), NPROJ}; pg8::gemm_phase(lds, DM, DM, DM, S, E); }
    else if constexpr (q == 2) phase_stepA(p, l, lds);
    else if constexpr (q == 3) phase_scan(p, l, lds);
    else if constexpr (q == 4) phase_stepC(p, l, lds);
    else if constexpr (q == 5) { pg8::BranchOrder S{(const char*)(ws + OFF_OCAT), (const char*)(ws + OFF_WBR), M_TOK / 256, NMG / 256, G, c};
              pg8::EpiBf16<0> E{(bf16_t*)(ws + OFF_PB), NMG}; pg8::gemm_phase(lds, DM, 512, 512, S, E); }
    else if constexpr (q == 6) { pg8::TileOrder S{(const char*)(ws + OFF_H), (const char*)(ws + OFF_WMG), DM, DM, M_TOK / 256, NMG / 256, G, c, DM / 64};
              pg8::EpiMerge E{(const bf16_t*)(ws + OFF_PB), (bf16_t*)(ws + OFF_OCAT)}; pg8::gemm_phase(lds, DM, DM, DM, S, E); }
    else if constexpr (q == 7) { pg8::SplitOrder S{(const char*)(ws + OFF_OCAT), (const char*)(ws + OFF_WOUT), DM, DM, G, c, DM / 64};
              pg8::EpiResid E{l == 0 ? p.in[I_XP] : p.out, l == 0 ? p.in[I_XS] : p.out + O_YS, p.out, (float*)(ws + OFF_BIG)}; pg8::gemm_phase(lds, DM, DM, DM, S, E); }
    else if constexpr (q == 8) norm_rows2(p.out, l == 0 ? p.in[I_XS] : p.out + O_YS, p.in[I_NFG] + l * DM, (bf16_t*)(ws + OFF_H), (const float*)(ws + OFF_BIG), p.out);
    else if constexpr (q == 9) { pg8::FfnOrder S{(const char*)(ws + OFF_H), (const char*)(ws + OFF_WFI), G, c};
              pg8::EpiFfn E{(bf16_t*)(ws + OFF_ACT), (bf16_t*)(ws + OFF_HALO), p.in[I_FCW] + (size_t)l * 3 * DFF, p.in[I_FCB] + (size_t)l * DFF, (float*)(ws + OFF_PARTF)}; pg8::gemm_phase(lds, DM, DM, DM, S, E); }
    else if constexpr (q == 10) phase_ffn_fix(p, l);
    else { pg8::SplitOrder S{(const char*)(ws + OFF_ACT), (const char*)(ws + OFF_WFO), DFF, DFF, G, c, DFF / 64};
               pg8::EpiResid E{p.out, p.out + O_YS, p.out, (float*)(ws + OFF_BIG)}; pg8::gemm_phase(lds, DFF, DFF, DFF, S, E); }
}

__global__ void __launch_bounds__(512, 2) fwd_kernel(Params p, int ph_lo, int ph_hi) {
    extern __shared__ __attribute__((aligned(16))) unsigned char shm[];
    LAS unsigned char* lds = (LAS unsigned char*)shm;
    volatile LAS unsigned* stw = (volatile LAS unsigned*)(lds + LDS_BYTES - 16);
    if (threadIdx.x == 0) { stw[0] = 0u; stw[1] = 0u; }
    __syncthreads();
    XcdBarrier xb{(unsigned*)(p.ws + OFF_BAR), 0u, stw};
    if (ph_hi - ph_lo > 1) xb = xcd_barrier_post((unsigned*)(p.ws + OFF_BAR), stw);
    if (ph_lo < 0) { __threadfence(); cg::this_grid().sync(); }
#define RUN(PH) if (ph_lo <= PH && PH < ph_hi) { run_phase<PH>(p, lds); if (PH + 1 < ph_hi) xcd_barrier(xb); }
    RUN(0) RUN(1) RUN(2) RUN(3) RUN(4) RUN(5) RUN(6) RUN(7) RUN(8) RUN(9) RUN(10) RUN(11)
    RUN(12) RUN(13) RUN(14) RUN(15) RUN(16) RUN(17) RUN(18) RUN(19) RUN(20) RUN(21) RUN(22) RUN(23) RUN(24)
#undef RUN
}

extern "C" void kernel_launch(void* const* d_in, const int* in_sizes, int n_in, void* d_out, int out_size, void* d_ws, size_t ws_size, hipStream_t stream) {
    static int grid = 0;
    if (grid == 0) {
        if (n_in != 29 || (size_t)out_size != O_END || ws_size < WS_TOTAL) { fprintf(stderr, "kernel_launch: unexpected shapes n_in %d out %d ws %zu (need %zu)\n", n_in, out_size, ws_size, (size_t)WS_END); grid = -1; return; }
        int dev = 0, cus = 0, per_cu = 0;
        (void)hipGetDevice(&dev); (void)hipDeviceGetAttribute(&cus, hipDeviceAttributeMultiprocessorCount, dev);
        if (hipFuncSetAttribute((const void*)fwd_kernel, hipFuncAttributeMaxDynamicSharedMemorySize, LDS_BYTES) != hipSuccess) { fprintf(stderr, "kernel_launch: hipFuncSetAttribute failed\n"); grid = -1; return; }
        if (hipOccupancyMaxActiveBlocksPerMultiprocessor(&per_cu, (const void*)fwd_kernel, 512, LDS_BYTES) != hipSuccess || per_cu < 1) { fprintf(stderr, "kernel_launch: occupancy query says %d\n", per_cu); per_cu = 1; }
        (void)hipGetLastError();
        grid = cus;
        if (grid < 128) grid = -1;
    }
    if (grid < 0) return;
    Params p{};
    for (int i = 0; i < 29; ++i) p.in[i] = (const float*)d_in[i];
    p.out = (float*)d_out; p.ws = (unsigned char*)d_ws;
#if MK_MULTI
    for (int ph = 0; ph < N_PHASES; ++ph) hipLaunchKernelGGL(fwd_kernel, dim3(grid), dim3(512), LDS_BYTES, stream, p, ph, ph + 1);
#else
    (void)hipMemsetAsync((unsigned char*)d_ws + OFF_BAR, 0, XCD_BAR_WORDS * 4, stream);
    int lo = 0, hi = N_PHASES;
    void* args[] = {&p, &lo, &hi};
    hipError_t e = hipLaunchCooperativeKernel((const void*)fwd_kernel, dim3(grid), dim3(512), args, LDS_BYTES, stream);
    if (e != hipSuccess) fprintf(stderr, "cooperative launch failed: %s (grid %d)\n", hipGetErrorString(e), grid);
#endif
}
```

```cpp
#include <hip/hip_runtime.h>
#include <hip/hip_cooperative_groups.h>
#include <cstdio>
namespace cg = cooperative_groups;

#ifndef MK_MULTI
#define MK_MULTI 0
#endif

#define LAS __attribute__((address_space(3)))
typedef unsigned short bf16_t;
typedef short bf16x8 __attribute__((ext_vector_type(8)));
typedef float f32x4 __attribute__((ext_vector_type(4)));
typedef unsigned u32x4 __attribute__((ext_vector_type(4)));
typedef unsigned u32x2 __attribute__((ext_vector_type(2)));

constexpr int M_TOK = 18432, DM = 2048, NPROJ = 7936, NMG = 8192, DFF = 5504, NFI = 11008, NIN = 15896;
constexpr int NCHUNK = 288, NITEM = 1152;
constexpr int PROMPT_ROWS = 16384;
constexpr int C_GLA_Q = 0, C_GLA_K = 256, C_GLA_V = 512, C_GLA_G = 1024, C_HG_Q = 1536, C_HG_F = 2048, C_HG_I = 2560, C_HG_G = 3072,
              C_GDN_QKV = 3584, C_GDN_Z = 5120, C_RET_Q = 5632, C_RET_K = 6144, C_RET_V = 6656, C_RET_G = 7168, C_GLA_LR = 7680,
              C_GDN_B = 7696, C_GDN_A = 7700;
constexpr size_t SZ_WIN = (size_t)NPROJ * DM * 2, SZ_WMG = (size_t)NMG * DM * 2, SZ_WBR = (size_t)4 * DM * 512 * 2, SZ_WOUT = (size_t)DM * DM * 2,
                 SZ_WFI = (size_t)NFI * DM * 2, SZ_WFO = (size_t)DM * DFF * 2, SZ_H = (size_t)M_TOK * DM * 2;
constexpr size_t OFF_WIN = 0, OFF_WMG = OFF_WIN + SZ_WIN, OFF_WBR = OFF_WMG + SZ_WMG, OFF_WOUT = OFF_WBR + SZ_WBR, OFF_WFI = OFF_WOUT + SZ_WOUT,
                 OFF_WFO = OFF_WFI + SZ_WFI, OFF_H = OFF_WFO + SZ_WFO, OFF_OCAT = OFF_H + SZ_H, OFF_BIG = OFF_OCAT + SZ_H;
constexpr size_t OFF_PROJ = OFF_BIG, SZ_PROJ = (size_t)M_TOK * NPROJ * 2;
constexpr size_t OFF_ST_GLA = OFF_PROJ + SZ_PROJ, SZ_ST64 = (size_t)NITEM * 128 * 64 * 2, SZ_ST128 = (size_t)NITEM * 128 * 128 * 2;
constexpr size_t OFF_ST_HG = OFF_ST_GLA + SZ_ST64, OFF_ST_RET = OFF_ST_HG + SZ_ST128, OFF_ST_GDN = OFF_ST_RET + SZ_ST128, OFF_A_GDN = OFF_ST_GDN + SZ_ST128,
                 OFF_GQX = OFF_A_GDN + SZ_ST128, OFF_GO0 = OFF_GQX + SZ_ST64, OFF_DEC_GLA = OFF_GO0 + SZ_ST64, OFF_DEC_HG = OFF_DEC_GLA + (size_t)NITEM * 64 * 4,
                 OFF_MIX_END = OFF_DEC_HG + (size_t)NITEM * 128 * 4;
constexpr size_t OFF_PB = OFF_BIG;
constexpr size_t OFF_AU = OFF_BIG, OFF_PARTF = OFF_AU + (size_t)64 * 1024 * 1024  , OFF_HALO = OFF_AU + (size_t)128 * 1024 * 1024, OFF_ACT = OFF_AU + (size_t)M_TOK * NFI * 2, WS_END = OFF_ACT + (size_t)M_TOK * DFF * 2;
constexpr size_t O_YP = 0, O_YS = 33554432, O_PGLA = O_YS + 4194304, O_PHG = O_PGLA + 131072, O_PGDN = O_PHG + 262144, O_PRET = O_PGDN + 262144,
                 O_PGC = O_PRET + 262144, O_PFC = O_PGC + 18432, O_SGLA = O_PFC + 44032, O_SHG = O_SGLA + 2097152, O_SGDN = O_SHG + 4194304,
                 O_SRET = O_SGDN + 4194304, O_SGC = O_SRET + 4194304, O_SFC = O_SGC + 294912, O_END = O_SFC + 704512;
constexpr size_t OFF_BAR = WS_END, WS_TOTAL = WS_END + 16384;
constexpr int LDS_BYTES = 147456;

enum { I_XP = 0, I_XS, I_SGLA, I_SHG, I_SGDN, I_SRET, I_CGDN, I_CFFN, I_NMG, I_WIN, I_WGK, I_BGK, I_GLANG, I_LB, I_HGNG, I_GCW, I_ALOG, I_DTB, I_GDNNG,
       I_RETNG, I_RETNB, I_WBR, I_WOUT, I_NFG, I_WFI, I_FCW, I_FCB, I_WFO, I_NFIN };

struct Params { const float* in[29]; float* out; unsigned char* ws; };

typedef __bf16 bf16x2_t __attribute__((ext_vector_type(2)));
typedef float f32x2_t __attribute__((ext_vector_type(2)));
__device__ __forceinline__ unsigned cvt_pk_bf16(float lo, float hi) { f32x2_t f = {lo, hi}; bf16x2_t r = __builtin_convertvector(f, bf16x2_t); return __builtin_bit_cast(unsigned, r); }
__device__ __forceinline__ bf16_t f2bf(float f) { return (bf16_t)(cvt_pk_bf16(f, 0.f) & 0xffffu); }
__device__ __forceinline__ float bf2f(bf16_t b) { return __uint_as_float(((unsigned)b) << 16); }
__device__ __forceinline__ float bflo(unsigned w) { return __uint_as_float(w << 16); }
__device__ __forceinline__ float bfhi(unsigned w) { return __uint_as_float(w & 0xffff0000u); }
__device__ __forceinline__ void unpack8(u32x4 w, float* f) { f[0] = bflo(w[0]); f[1] = bfhi(w[0]); f[2] = bflo(w[1]); f[3] = bfhi(w[1]); f[4] = bflo(w[2]); f[5] = bfhi(w[2]); f[6] = bflo(w[3]); f[7] = bfhi(w[3]); }
__device__ __forceinline__ u32x4 pack8(const float* f) { u32x4 w; w[0] = cvt_pk_bf16(f[0], f[1]); w[1] = cvt_pk_bf16(f[2], f[3]); w[2] = cvt_pk_bf16(f[4], f[5]); w[3] = cvt_pk_bf16(f[6], f[7]); return w; }
__device__ __forceinline__ float sigm(float x) { return __builtin_amdgcn_rcpf(1.f + __expf(-x)); }
__device__ __forceinline__ float silu(float x) { return x * __builtin_amdgcn_rcpf(1.f + __expf(-x)); }
__device__ __forceinline__ float expc(float x) { return __expf(fminf(x, 80.f)); }
__device__ __forceinline__ float logsig(float x) { return fminf(x, 0.f) - log1pf(__expf(-fabsf(x))); }
__device__ __forceinline__ float softplus(float x) { return fmaxf(x, 0.f) + log1pf(__expf(-fabsf(x))); }

__device__ __forceinline__ void lds_barrier() { asm volatile("s_waitcnt lgkmcnt(0)" ::: "memory"); __builtin_amdgcn_s_barrier(); asm volatile("" ::: "memory"); }

struct ChunkInfo { int row0; int first, last, sample, b; float pos0; };
__device__ __forceinline__ ChunkInfo chunk_info(int cgi) {
    ChunkInfo c; c.row0 = cgi * 64;
    if (cgi < 256) { const int ci = cgi & 127; c.sample = 0; c.b = cgi >> 7; c.first = (ci == 0); c.last = (ci == 127); c.pos0 = (float)(ci * 64); }
    else { c.sample = 1; c.b = cgi - 256; c.first = 1; c.last = 1; c.pos0 = 4096.f; }
    return c;
}

namespace pg8 {
constexpr int BM = 256, BK = 64, HALF = 128, HTB = HALF * BK * 2, STAGE_BYTES = 8 * HTB, NXCD = 8, WGM = 8;
__device__ __forceinline__ int lds_byte(int r, int c) { const int st = (r >> 4) * 2 + (c >> 5), rr = r & 15, cc = c & 31, ob = rr * 64 + cc * 2; return st * 1024 + (ob ^ (((ob >> 9) & 1) << 5)); }
__device__ __forceinline__ void stage_rc(int b, int& R, int& C) { const int st = b / 1024, sb = b % 1024, swz = sb ^ (((sb >> 9) & 1) << 5); R = (st >> 1) * 16 + swz / 64; C = (st & 1) * 32 + (swz % 64) / 2; }
__device__ __forceinline__ int perm32(int rho) { const int n = rho >> 4, i = rho & 15; return 8 * (i >> 2) + 4 * n + (i & 3); }
struct Unit { int pm, pn, aux, nt; const char* a; const char* b; };
__device__ __forceinline__ void tile_of(int L, int nM, int nN, int& pm, int& pn) {
    const int nwg = nM * nN; int wgid = L;
    { const int q = nwg / NXCD, r = nwg % NXCD, xcd = wgid % NXCD, off = wgid / NXCD; wgid = (xcd < r ? xcd * (q + 1) : r * (q + 1) + (xcd - r) * q) + off; }
    const int nig = WGM * nN, gid = wgid / nig, fm = gid * WGM, gsz = (nM - fm) < WGM ? (nM - fm) : WGM;
    pm = fm + ((wgid % nig) % gsz); pn = (wgid % nig) / gsz;
}
struct TileOrder {
    const char* A; const char* B; int lda, ldb, nM, nN, G, c, nt;
    __device__ __forceinline__ bool next(int i, Unit& u) const {
        const long L = (long)i * G + c; if (L >= (long)nM * nN) return false;
        tile_of((int)L, nM, nN, u.pm, u.pn); u.aux = 0; u.nt = nt;
        u.a = A + (size_t)u.pm * 256 * lda * 2; u.b = B + (size_t)u.pn * 256 * ldb * 2; return true;
    }
};
struct BranchOrder {
    const char* A; const char* B; int nM, nN, G, c;
    __device__ __forceinline__ bool next(int i, Unit& u) const {
        const long L = (long)i * G + c; if (L >= (long)nM * nN) return false;
        tile_of((int)L, nM, nN, u.pm, u.pn); u.aux = 0; u.nt = 8;
        const int n = u.pn >> 3, pn = u.pn & 7;
        u.a = A + ((size_t)u.pm * 256 * DM + (size_t)n * 512) * 2; u.b = B + ((size_t)n * DM * 512 + (size_t)pn * 256 * 512) * 2; return true;
    }
};

struct SplitOrder {
    const char* A; const char* B; int lda, ldb, G, c, nt;
    __device__ __forceinline__ bool next(int i, Unit& u) const {
        if (G != 256) { const long L = (long)i * G + c; if (L >= 576) return false; tile_of((int)L, 72, 8, u.pm, u.pn); u.aux = 0; u.nt = nt;
            u.a = A + (size_t)u.pm * 256 * lda * 2; u.b = B + (size_t)u.pn * 256 * ldb * 2; return true; }
        if (i < 2) { tile_of(i * 256 + c, 64, 8, u.pm, u.pn); u.aux = 0; u.nt = nt; u.a = A + (size_t)u.pm * 256 * lda * 2; u.b = B + (size_t)u.pn * 256 * ldb * 2; return true; }
        if (i > 2) return false;
        const int j = c >> 2, q = c & 3, per = ((nt / 4 + 1) / 2) * 2, kt0 = q * per;
        u.pm = 64 + (j >> 3); u.pn = j & 7; u.aux = 1 + q; u.nt = min(per, nt - kt0);
        u.a = A + (size_t)u.pm * 256 * lda * 2 + (size_t)kt0 * 128; u.b = B + (size_t)u.pn * 256 * ldb * 2 + (size_t)kt0 * 128; return true;
    }
};

constexpr int FFN_SPLIT_PM0 = 48, FFN_SPLIT_PN = 42;
struct FfnOrder {
    const char* A; const char* B; int G, c;
    __device__ __forceinline__ bool next(int i, Unit& u) const {
        if (G != 256) { const long L = (long)i * G + c; if (L >= 72 * 43) return false; tile_of((int)L, 72, 43, u.pm, u.pn); u.aux = 0; u.nt = DM / 64;
            u.a = A + (size_t)u.pm * 256 * DM * 2; u.b = B + (size_t)u.pn * 256 * DM * 2; return true; }
        if (i < 12) { const int L = i * 256 + c;
            if (L < 72 * 42) tile_of(L, 72, 42, u.pm, u.pn); else { u.pm = L - 72 * 42; u.pn = FFN_SPLIT_PN; }
            u.aux = 0; u.nt = DM / 64; u.a = A + (size_t)u.pm * 256 * DM * 2; u.b = B + (size_t)u.pn * 256 * DM * 2; return true; }
        if (i > 12 || c >= 96) return false;
        const int j = c >> 2, q = c & 3;
        u.pm = FFN_SPLIT_PM0 + j; u.pn = FFN_SPLIT_PN; u.aux = 1 + q; u.nt = 8;
        u.a = A + (size_t)u.pm * 256 * DM * 2 + (size_t)q * 8 * 128; u.b = B + (size_t)u.pn * 256 * DM * 2 + (size_t)q * 8 * 128; return true;
    }
};

template <class Epi, class Sched>
__device__ __forceinline__ void gemm_phase(LAS unsigned char* lds, const int lda, const int ldb, const int K, const Sched& S, const Epi& E) {
    const int tid = threadIdx.x, wid = __builtin_amdgcn_readfirstlane(tid >> 6), lane = tid & 63, wr = wid >> 2, wc = wid & 3, fr = lane & 15, fq = lane >> 4;
    unsigned voffA[2], voffB[2];
#pragma unroll
    for (int i = 0; i < 2; ++i) { int R, C; stage_rc(tid * 16 + i * 8192, R, C); const int Rb = Epi::PERM ? ((R & ~31) + perm32(R & 31)) : R;
        voffA[i] = (unsigned)(R * lda + C) * 2u; voffB[i] = (unsigned)(Rb * ldb + C) * 2u; }
    const size_t kstep = (size_t)(BK * 2);
    const size_t hstepA = (size_t)HALF * lda * 2, hstepB = (size_t)HALF * ldb * 2;
    const unsigned ldsw = (unsigned)wid * 1024u;
    const int aoff = lds_byte(wr * 64 + fr, fq * 8), boff = lds_byte(wc * 32 + fr, fq * 8);
#define PG8_SA(b, h) (((b) * 2 + (h)) * HTB)
#define PG8_SB(b, h) ((4 + (b) * 2 + (h)) * HTB)
#define PG8_STAGE(bufoff, gbase, voff) do { _Pragma("unroll") for (int _i = 0; _i < 2; ++_i) \
        __builtin_amdgcn_global_load_lds((const unsigned*)((const char*)(gbase) + (voff)[_i]), (LAS unsigned*)(lds + (bufoff) + ldsw + _i * 8192), 16, 0, 0); } while (0)
#define PG8_LDA(dst, b, h) do { _Pragma("unroll") for (int m = 0; m < 4; ++m) _Pragma("unroll") for (int k = 0; k < 2; ++k) dst[m][k] = *(const LAS bf16x8*)(lds + PG8_SA(b, h) + aoff + m * 2048 + k * 1024); } while (0)
#define PG8_LDB(dst, b, h) do { _Pragma("unroll") for (int n = 0; n < 2; ++n) _Pragma("unroll") for (int k = 0; k < 2; ++k) dst[n][k] = *(const LAS bf16x8*)(lds + PG8_SB(b, h) + boff + n * 2048 + k * 1024); } while (0)
#define PG8_MMA(ai, bj, At, Bt) do { __builtin_amdgcn_s_setprio(1); _Pragma("unroll") for (int m = 0; m < 4; ++m) _Pragma("unroll") for (int n = 0; n < 2; ++n) _Pragma("unroll") for (int k = 0; k < 2; ++k) \
        acc[ai][bj][m][n] = __builtin_amdgcn_mfma_f32_16x16x32_bf16(Bt[n][k], At[m][k], acc[ai][bj][m][n], 0, 0, 0); __builtin_amdgcn_s_setprio(0); } while (0)
#define PG8_WAIT_V(n) asm volatile("s_waitcnt vmcnt(" #n ")" ::: "memory")
#define PG8_WAIT_L(n) asm volatile("s_waitcnt lgkmcnt(" #n ")" ::: "memory")
#define PG8_BAR __builtin_amdgcn_s_barrier()
#define PG8_SCHED __builtin_amdgcn_sched_barrier(0)
    Unit cur, nxt; int ui = 0;
    if (!S.next(0, cur)) return;
    f32x4 acc[2][2][4][2];
#pragma unroll
    for (int a = 0; a < 2; ++a)
#pragma unroll
        for (int b = 0; b < 2; ++b)
#pragma unroll
            for (int m = 0; m < 4; ++m)
#pragma unroll
                for (int n = 0; n < 2; ++n) acc[a][b][m][n] = (f32x4){0.f, 0.f, 0.f, 0.f};
    bf16x8 At[4][2], B0[2][2], B1[2][2];
    const char* cA = cur.a; const char* cB = cur.b;
    PG8_STAGE(PG8_SB(0, 0), cB, voffB); PG8_STAGE(PG8_SA(0, 0), cA, voffA); PG8_STAGE(PG8_SB(0, 1), cB + hstepB, voffB); PG8_STAGE(PG8_SA(0, 1), cA + hstepA, voffA);
    if (wr == 1) PG8_BAR;
    PG8_WAIT_V(4); PG8_BAR;
    PG8_STAGE(PG8_SB(1, 0), cB + kstep, voffB); PG8_STAGE(PG8_SA(1, 0), cA + kstep, voffA); PG8_STAGE(PG8_SB(1, 1), cB + hstepB + kstep, voffB);
    PG8_WAIT_V(6); PG8_BAR;
    for (;;) {
        const bool has_next = S.next(ui + 1, nxt);
        const char* nA = has_next ? nxt.a : cA; const char* nB = has_next ? nxt.b : cB;
        const int cnt = cur.nt;
        for (int t = 0; t < cnt; t += 2) {
            const bool last = (t == cnt - 2);
            const char* a1 = cA + (size_t)(t + 1) * kstep;
            const char* a2 = last ? nA : cA + (size_t)(t + 2) * kstep; const char* b2 = last ? nB : cB + (size_t)(t + 2) * kstep;
            const char* a3 = a2 + kstep; const char* b3 = b2 + kstep;
            PG8_LDB(B0, 0, 0); PG8_SCHED; PG8_LDA(At, 0, 0); PG8_STAGE(PG8_SA(1, 1), a1 + hstepA, voffA);
            PG8_WAIT_L(8); PG8_BAR; PG8_WAIT_L(0); PG8_MMA(0, 0, At, B0); PG8_BAR; PG8_SCHED;
            PG8_LDB(B1, 0, 1); PG8_STAGE(PG8_SB(0, 0), b2, voffB);
            PG8_BAR; PG8_WAIT_L(0); PG8_MMA(0, 1, At, B1); PG8_BAR;
            PG8_LDA(At, 0, 1); PG8_STAGE(PG8_SA(0, 0), a2, voffA);
            PG8_BAR; PG8_WAIT_L(0); PG8_MMA(1, 0, At, B0); PG8_BAR; PG8_SCHED;
            PG8_STAGE(PG8_SB(0, 1), b2 + hstepB, voffB);
            PG8_WAIT_V(6); PG8_BAR; PG8_MMA(1, 1, At, B1); PG8_BAR;
            PG8_LDB(B0, 1, 0); PG8_SCHED; PG8_LDA(At, 1, 0); PG8_STAGE(PG8_SA(0, 1), a2 + hstepA, voffA);
            PG8_WAIT_L(8); PG8_BAR; PG8_WAIT_L(0); PG8_MMA(0, 0, At, B0); PG8_BAR; PG8_SCHED;
            PG8_LDB(B1, 1, 1); PG8_STAGE(PG8_SB(1, 0), b3, voffB);
            PG8_BAR; PG8_WAIT_L(0); PG8_MMA(0, 1, At, B1); PG8_BAR;
            PG8_LDA(At, 1, 1); PG8_STAGE(PG8_SA(1, 0), a3, voffA);
            PG8_BAR; PG8_WAIT_L(0); PG8_MMA(1, 0, At, B0); PG8_BAR; PG8_SCHED;
            PG8_STAGE(PG8_SB(1, 1), b3 + hstepB, voffB);
            PG8_WAIT_V(6); PG8_BAR; PG8_MMA(1, 1, At, B1); PG8_BAR;
        }
        E(acc, cur, wr, wc, fr, fq);
        if (!has_next) break;
#pragma unroll
        for (int a = 0; a < 2; ++a)
#pragma unroll
            for (int b = 0; b < 2; ++b)
#pragma unroll
                for (int m = 0; m < 4; ++m)
#pragma unroll
                    for (int n = 0; n < 2; ++n) acc[a][b][m][n] = (f32x4){0.f, 0.f, 0.f, 0.f};
        cur = nxt; cA = nA; cB = nB; ++ui;
    }
    PG8_WAIT_V(0);
    if (wr == 0) PG8_BAR;
    PG8_BAR;
#undef PG8_SA
#undef PG8_SB
#undef PG8_STAGE
#undef PG8_LDA
#undef PG8_LDB
#undef PG8_MMA
#undef PG8_WAIT_V
#undef PG8_WAIT_L
#undef PG8_BAR
#undef PG8_SCHED
}

template <int ACT> struct EpiBf16 {
    static constexpr bool PERM = true;
    bf16_t* O; int ldc;
    __device__ __forceinline__ void operator()(const f32x4 (&acc)[2][2][4][2], const Unit& u, int wr, int wc, int fr, int fq) const {
        const int row0 = u.pm * BM + wr * 64 + fr, col0 = u.pn * BM + wc * 32 + 8 * fq;
#pragma unroll
        for (int ai = 0; ai < 2; ++ai)
#pragma unroll
            for (int m = 0; m < 4; ++m) { bf16_t* rowp = O + (size_t)(row0 + ai * HALF + m * 16) * ldc + col0;
#pragma unroll
                for (int bj = 0; bj < 2; ++bj) { f32x4 v0 = acc[ai][bj][m][0], v1 = acc[ai][bj][m][1];
                    if (ACT == 1) { for (int j = 0; j < 4; ++j) { v0[j] = sigm(v0[j]); v1[j] = sigm(v1[j]); } }
                    u32x4 w; w[0] = cvt_pk_bf16(v0[0], v0[1]); w[1] = cvt_pk_bf16(v0[2], v0[3]); w[2] = cvt_pk_bf16(v1[0], v1[1]); w[3] = cvt_pk_bf16(v1[2], v1[3]);
                    *(u32x4*)(rowp + bj * HALF) = w; } }
    }
};
struct EpiMerge {
    static constexpr bool PERM = true;
    const bf16_t* pb; bf16_t* mixed;
    __device__ __forceinline__ void operator()(const f32x4 (&acc)[2][2][4][2], const Unit& u, int wr, int wc, int fr, int fq) const {
        const int row0 = u.pm * BM + wr * 64 + fr, d0 = u.pn * 64 + wc * 16 + fq * 4;
        u32x2 pw[2][4][4];
#pragma unroll
        for (int ai = 0; ai < 2; ++ai)
#pragma unroll
            for (int m = 0; m < 4; ++m)
#pragma unroll
                for (int n = 0; n < 4; ++n) pw[ai][m][n] = *(const u32x2*)(pb + (size_t)(row0 + ai * HALF + m * 16) * NMG + n * DM + d0);
#pragma unroll
        for (int ai = 0; ai < 2; ++ai)
#pragma unroll
            for (int m = 0; m < 4; ++m) { const size_t row = (size_t)(row0 + ai * HALF + m * 16);
                float o[4] = {0.f, 0.f, 0.f, 0.f};
#pragma unroll
                for (int n = 0; n < 4; ++n) { const f32x4 a = acc[ai][n >> 1][m][n & 1]; const u32x2 w = pw[ai][m][n];
                    o[0] += sigm(a[0]) * bflo(w[0]); o[1] += sigm(a[1]) * bfhi(w[0]); o[2] += sigm(a[2]) * bflo(w[1]); o[3] += sigm(a[3]) * bfhi(w[1]); }
                u32x2 w; w[0] = cvt_pk_bf16(o[0], o[1]); w[1] = cvt_pk_bf16(o[2], o[3]);
                *(u32x2*)(mixed + row * DM + d0) = w; }
    }
};
__device__ __forceinline__ float dpp_ror1(float x) { return __builtin_bit_cast(float, __builtin_amdgcn_mov_dpp(__builtin_bit_cast(int, x), 0x121, 0xF, 0xF, true)); }
__device__ __forceinline__ float dpp_ror2(float x) { return __builtin_bit_cast(float, __builtin_amdgcn_mov_dpp(__builtin_bit_cast(int, x), 0x122, 0xF, 0xF, true)); }
struct EpiFfn {
    static constexpr bool PERM = true;
    bf16_t* act; bf16_t* halo; const float* cw; const float* cb; float* partf;
    __device__ __forceinline__ void operator()(const f32x4 (&acc)[2][2][4][2], const Unit& u, int wr, int wc, int fr, int fq) const {
        if (u.aux) {
            float* pq = partf + ((size_t)(u.aux - 1) * 24 + (u.pm - FFN_SPLIT_PM0)) * 65536;
#pragma unroll
            for (int ai = 0; ai < 2; ++ai)
#pragma unroll
                for (int m = 0; m < 4; ++m)
#pragma unroll
                    for (int bj = 0; bj < 2; ++bj)
#pragma unroll
                        for (int n = 0; n < 2; ++n) *(f32x4*)(pq + (size_t)(ai * HALF + wr * 64 + 16 * m + fr) * 256 + bj * HALF + wc * 32 + 8 * fq + 4 * n) = acc[ai][bj][m][n];
            return;
        }
        const int j0 = u.pn * 128 + wc * 32 + 8 * fq;
        float w0[8], w1[8], w2[8], bb[8];
#pragma unroll
        for (int c = 0; c < 8; c += 4) { const float4 a = *(const float4*)(cw + j0 + c), b = *(const float4*)(cw + DFF + j0 + c), d = *(const float4*)(cw + 2 * DFF + j0 + c), e = *(const float4*)(cb + j0 + c);
            w0[c] = a.x; w0[c + 1] = a.y; w0[c + 2] = a.z; w0[c + 3] = a.w; w1[c] = b.x; w1[c + 1] = b.y; w1[c + 2] = b.z; w1[c + 3] = b.w;
            w2[c] = d.x; w2[c + 1] = d.y; w2[c + 2] = d.z; w2[c + 3] = d.w; bb[c] = e.x; bb[c + 1] = e.y; bb[c + 2] = e.z; bb[c + 3] = e.w; }
#pragma unroll
        for (int ai = 0; ai < 2; ++ai) {
            const int R0 = u.pm * BM + ai * HALF + wr * 64, cgi = R0 >> 6;
            float p1[8], p2[8];
#pragma unroll
            for (int e = 0; e < 8; ++e) { p1[e] = 0.f; p2[e] = 0.f; }
#pragma unroll
            for (int m = 0; m < 4; ++m) {
                const size_t row = (size_t)(R0 + 16 * m + fr);
                float y[8], ac[8], uc[8];
#pragma unroll
                for (int e = 0; e < 8; ++e) {
                    const float a = acc[ai][0][m][e >> 2][e & 3], uu = acc[ai][1][m][e >> 2][e & 3];
                    const float r1c = dpp_ror1(a), r2c = dpp_ror2(a);
                    const float a1 = (fr >= 1) ? r1c : p1[e], a2 = (fr >= 2) ? r2c : p2[e];
                    p1[e] = r1c; p2[e] = r2c;
                    y[e] = silu(w0[e] * a2 + w1[e] * a1 + w2[e] * a + bb[e]) * uu; ac[e] = a; uc[e] = uu;
                }
                if (m > 0 || fr >= 2) *(u32x4*)(act + row * DFF + j0) = pack8(y);
                const int slot = (m == 0 && fr < 2) ? fr : ((m == 3 && fr >= 14) ? fr - 12 : -1);
                if (slot >= 0) { bf16_t* hp = halo + ((size_t)(cgi * 4 + slot) * 2) * DFF + j0; *(u32x4*)hp = pack8(ac); *(u32x4*)(hp + DFF) = pack8(uc); }
            }
        }
    }
};
struct EpiResid {
    static constexpr bool PERM = false;
    const float* xin_p; const float* xin_s; float* xout; float* part;
    __device__ __forceinline__ void operator()(const f32x4 (&acc)[2][2][4][2], const Unit& u, int wr, int wc, int fr, int fq) const {
        const int row0 = u.pm * BM + wr * 64 + fr, col0 = u.pn * BM + wc * 32 + 4 * fq;
        if (u.aux == 0) {
            const float* xin = (u.pm * BM < PROMPT_ROWS) ? xin_p : (xin_s - (size_t)PROMPT_ROWS * DM);
#pragma unroll
            for (int ai = 0; ai < 2; ++ai) {
                f32x4 xv[4][2][2];
#pragma unroll
                for (int m = 0; m < 4; ++m)
#pragma unroll
                    for (int bj = 0; bj < 2; ++bj)
#pragma unroll
                        for (int n = 0; n < 2; ++n) xv[m][bj][n] = *(const f32x4*)(xin + (size_t)(row0 + ai * HALF + m * 16) * DM + col0 + bj * HALF + n * 16);
#pragma unroll
                for (int m = 0; m < 4; ++m)
#pragma unroll
                    for (int bj = 0; bj < 2; ++bj)
#pragma unroll
                        for (int n = 0; n < 2; ++n) *(f32x4*)(xout + (size_t)(row0 + ai * HALF + m * 16) * DM + col0 + bj * HALF + n * 16) = acc[ai][bj][m][n] + xv[m][bj][n];
            }
        } else {
            float* pq = part + (size_t)(u.aux - 1) * 2048 * DM - (size_t)PROMPT_ROWS * DM;
#pragma unroll
            for (int ai = 0; ai < 2; ++ai)
#pragma unroll
                for (int m = 0; m < 4; ++m) { const size_t ro = (size_t)(row0 + ai * HALF + m * 16) * DM + col0;
#pragma unroll
                    for (int bj = 0; bj < 2; ++bj)
#pragma unroll
                        for (int n = 0; n < 2; ++n) *(f32x4*)(pq + ro + bj * HALF + n * 16) = acc[ai][bj][m][n]; }
        }
    }
};
}

__device__ __forceinline__ int swz64(int row, int col, int ld) { return row * ld + ((((col >> 3) ^ ((row >> 4) & 7)) << 3) | (col & 7)); }
template <bool SWX = false, bool SWY = false, class F>
__device__ __forceinline__ void lds_mm(const LAS bf16_t* X, int ldx, const LAS bf16_t* Y, int ldy, int MB, int NB, int ksteps, F&& epi) {
    int tidl = threadIdx.x; asm volatile("" : "+v"(tidl));
    const int wid = tidl >> 6, lane = tidl & 63, fr = lane & 15, fq = lane >> 4;
    for (int blk = wid; blk < MB * NB; blk += 8) {
        const int mb = blk / NB, nb = blk - mb * NB;
        f32x4 a00 = {0.f, 0.f, 0.f, 0.f}, a01 = a00, a10 = a00, a11 = a00;
        const LAS bf16_t* xp = X + (mb * 32 + fr) * ldx;
        const LAS bf16_t* yp = Y + (nb * 32 + fr) * ldy;
        const int sx0 = SWX ? ((2 * mb) & 7) : 0, sx1 = SWX ? ((2 * mb + 1) & 7) : 0, sy0 = SWY ? ((2 * nb) & 7) : 0, sy1 = SWY ? ((2 * nb + 1) & 7) : 0;
        for (int k = 0; k < ksteps; ++k) {
            const int g = fq + 4 * k;
            const bf16x8 x0 = *(const LAS bf16x8*)(xp + ((g ^ sx0) << 3)), x1 = *(const LAS bf16x8*)(xp + 16 * ldx + ((g ^ sx1) << 3));
            const bf16x8 y0 = *(const LAS bf16x8*)(yp + ((g ^ sy0) << 3)), y1 = *(const LAS bf16x8*)(yp + 16 * ldy + ((g ^ sy1) << 3));
            a00 = __builtin_amdgcn_mfma_f32_16x16x32_bf16(y0, x0, a00, 0, 0, 0);
            a01 = __builtin_amdgcn_mfma_f32_16x16x32_bf16(y1, x0, a01, 0, 0, 0);
            a10 = __builtin_amdgcn_mfma_f32_16x16x32_bf16(y0, x1, a10, 0, 0, 0);
            a11 = __builtin_amdgcn_mfma_f32_16x16x32_bf16(y1, x1, a11, 0, 0, 0);
        }
        const int r = mb * 32 + fr, c = nb * 32 + fq * 4;
        epi(r, c, a00); epi(r, c + 16, a01); epi(r + 16, c, a10); epi(r + 16, c + 16, a11);
    }
}

__device__ __forceinline__ int merge_row(int cidx) { const int n = cidx >> 11, d = cidx & 2047, dl = d & 63; return (d >> 6) * 256 + (n >> 1) * 128 + (dl >> 4) * 32 + ((dl >> 2) & 3) * 8 + (n & 1) * 4 + (dl & 3); }
template <int MAP = 0>
__device__ __forceinline__ void conv_job(const float* __restrict__ src, int sld, int K, int scol0, int ncols, bf16_t* dst, int dld, int drow0, LAS unsigned* tl, int& rot, int first = 0, int cnt = 0) {
    const int nk = K / 64, nn = (ncols + 63) / 64, ntiles = nk * nn, G = cnt ? cnt : (int)gridDim.x, tid = threadIdx.x;
    const int kp = tid >> 4, n4 = (tid & 15) * 4, on = tid >> 3, okg = tid & 7;
    int t = ((int)blockIdx.x - first + G - rot) % G;
    float4 r0 = make_float4(0.f, 0.f, 0.f, 0.f), r1 = r0;
    if (t < ntiles) { const int tk = t / nn, tn = t - tk * nn;
        if (n4 < min(64, ncols - tn * 64)) { const float* sp = src + (size_t)(tk * 64 + 2 * kp) * sld + scol0 + tn * 64 + n4; r0 = *(const float4*)sp; r1 = *(const float4*)(sp + sld); } }
    LAS unsigned* tlbase = tl; int par = 0;
    for (; t < ntiles; t += G) {
        const int tk = t / nn, tn = t - tk * nn, k0 = tk * 64, n0 = tn * 64, nvalid = min(64, ncols - n0);
        tl = tlbase + par * (64 * 33); par ^= 1;
        tl[(n4 + 0) * 33 + kp] = cvt_pk_bf16(r0.x, r1.x); tl[(n4 + 1) * 33 + kp] = cvt_pk_bf16(r0.y, r1.y);
        tl[(n4 + 2) * 33 + kp] = cvt_pk_bf16(r0.z, r1.z); tl[(n4 + 3) * 33 + kp] = cvt_pk_bf16(r0.w, r1.w);
        lds_barrier();
        { const int t2 = t + G; r0 = make_float4(0.f, 0.f, 0.f, 0.f); r1 = r0;
          if (t2 < ntiles) { const int tk2 = t2 / nn, tn2 = t2 - tk2 * nn;
              if (n4 < min(64, ncols - tn2 * 64)) { const float* sp = src + (size_t)(tk2 * 64 + 2 * kp) * sld + scol0 + tn2 * 64 + n4; r0 = *(const float4*)sp; r1 = *(const float4*)(sp + sld); } } }
        if (on < nvalid) { u32x4 v; v[0] = tl[on * 33 + okg * 4]; v[1] = tl[on * 33 + okg * 4 + 1]; v[2] = tl[on * 33 + okg * 4 + 2]; v[3] = tl[on * 33 + okg * 4 + 3];
            int drow = drow0 + n0 + on;
            if (MAP == 1) drow = merge_row(n0 + on);
            if (MAP == 2) { const int sc = n0 + on, j = sc < DFF ? sc : sc - DFF; drow = (j >> 7) * 256 + (sc < DFF ? 0 : 128) + (j & 127); }
            *(u32x4*)(dst + (size_t)drow * dld + k0 + okg * 8) = v; }
    }
    lds_barrier();
    rot = (rot + ntiles) % G;
}

__device__ __forceinline__ float wave_sum(float v) {
#pragma unroll
    for (int o = 32; o >= 1; o >>= 1) v += __shfl_xor(v, o);
    return v;
}

template <bool FINAL>
__device__ __forceinline__ void norm_rows(const float* xp, const float* xs, const float* __restrict__ g, bf16_t* h, float* yout, const float* part, float* xwb) {
    const int wid = threadIdx.x >> 6;
    for (int r = blockIdx.x * 8 + wid; r < M_TOK; r += gridDim.x * 8) {
        int lane = threadIdx.x & 63; asm volatile("" : "+v"(lane));
        const float* xr = (r < PROMPT_ROWS) ? xp + (size_t)r * DM : xs + (size_t)(r - PROMPT_ROWS) * DM;
        float4 v[8], gv[8]; float ss = 0.f;
#pragma unroll
        for (int j = 0; j < 8; ++j) v[j] = *(const float4*)(xr + (j * 64 + lane) * 4);
#pragma unroll
        for (int j = 0; j < 8; ++j) gv[j] = *(const float4*)(g + (j * 64 + lane) * 4);
        if (part != nullptr && r >= PROMPT_ROWS) {
#pragma unroll
            for (int q = 0; q < 4; ++q) { const float* pr = part + ((size_t)q * 2048 + (r - PROMPT_ROWS)) * DM;
#pragma unroll
                for (int j = 0; j < 8; ++j) { const float4 a = *(const float4*)(pr + (j * 64 + lane) * 4); v[j].x += a.x; v[j].y += a.y; v[j].z += a.z; v[j].w += a.w; } }
            if (xwb != nullptr) {
#pragma unroll
                for (int j = 0; j < 8; ++j) *(float4*)(xwb + (size_t)r * DM + (j * 64 + lane) * 4) = v[j]; }
        }
#pragma unroll
        for (int j = 0; j < 8; ++j) ss += v[j].x * v[j].x + v[j].y * v[j].y + v[j].z * v[j].z + v[j].w * v[j].w;
        ss = wave_sum(ss);
        const float rs = rsqrtf(ss * (1.f / DM) + 1e-6f);
#pragma unroll
        for (int j = 0; j < 8; ++j) { const int c = (j * 64 + lane) * 4;
            const float o0 = v[j].x * rs * gv[j].x, o1 = v[j].y * rs * gv[j].y, o2 = v[j].z * rs * gv[j].z, o3 = v[j].w * rs * gv[j].w;
            if (FINAL) *(float4*)(yout + (size_t)r * DM + c) = make_float4(o0, o1, o2, o3);
            else { u32x2 w; w[0] = cvt_pk_bf16(o0, o1); w[1] = cvt_pk_bf16(o2, o3); *(u32x2*)(h + (size_t)r * DM + c) = w; } }
    }
}

template <bool FINAL = false>
__device__ __forceinline__ void norm_rows2(const float* xp, const float* xs, const float* __restrict__ g, bf16_t* h, const float* part, float* xwb, float* yout = nullptr) {
    const int wid = threadIdx.x >> 6, nw = gridDim.x * 8;
    for (int r0 = blockIdx.x * 8 + wid; r0 < M_TOK; r0 += 2 * nw) {
        int lane = threadIdx.x & 63; asm volatile("" : "+v"(lane));
        const int r1 = r0 + nw; const bool ok1 = r1 < M_TOK; const int r1c = ok1 ? r1 : r0;
        const float* xa = (r0 < PROMPT_ROWS) ? xp + (size_t)r0 * DM : xs + (size_t)(r0 - PROMPT_ROWS) * DM;
        const float* xb = (r1c < PROMPT_ROWS) ? xp + (size_t)r1c * DM : xs + (size_t)(r1c - PROMPT_ROWS) * DM;
        float4 va[8], vb[8], gv[8];
#pragma unroll
        for (int j = 0; j < 8; ++j) { va[j] = *(const float4*)(xa + (j * 64 + lane) * 4); vb[j] = *(const float4*)(xb + (j * 64 + lane) * 4); }
#pragma unroll
        for (int j = 0; j < 8; ++j) gv[j] = *(const float4*)(g + (j * 64 + lane) * 4);
#pragma unroll
        for (int q = 0; q < 2; ++q) {
            const int r = q ? r1c : r0;
            if (q == 0 || ok1) {
                float4 v[8];
#pragma unroll
                for (int j = 0; j < 8; ++j) v[j] = q ? vb[j] : va[j];
                if (part != nullptr && r >= PROMPT_ROWS) {
#pragma unroll
                    for (int pq = 0; pq < 4; ++pq) { const float* pr = part + ((size_t)pq * 2048 + (r - PROMPT_ROWS)) * DM;
#pragma unroll
                        for (int j = 0; j < 8; ++j) { const float4 a = *(const float4*)(pr + (j * 64 + lane) * 4); v[j].x += a.x; v[j].y += a.y; v[j].z += a.z; v[j].w += a.w; } }
                    if (xwb != nullptr) {
#pragma unroll
                        for (int j = 0; j < 8; ++j) *(float4*)(xwb + (size_t)r * DM + (j * 64 + lane) * 4) = v[j]; }
                }
                float ss = 0.f;
#pragma unroll
                for (int j = 0; j < 8; ++j) ss += v[j].x * v[j].x + v[j].y * v[j].y + v[j].z * v[j].z + v[j].w * v[j].w;
                ss = wave_sum(ss);
                const float rs = rsqrtf(ss * (1.f / DM) + 1e-6f);
#pragma unroll
                for (int j = 0; j < 8; ++j) { const int c = (j * 64 + lane) * 4;
                    if (FINAL) *(float4*)(yout + (size_t)r * DM + c) = make_float4(v[j].x * rs * gv[j].x, v[j].y * rs * gv[j].y, v[j].z * rs * gv[j].z, v[j].w * rs * gv[j].w);
                    else { u32x2 w; w[0] = cvt_pk_bf16(v[j].x * rs * gv[j].x, v[j].y * rs * gv[j].y); w[1] = cvt_pk_bf16(v[j].z * rs * gv[j].z, v[j].w * rs * gv[j].w);
                        *(u32x2*)(h + (size_t)r * DM + c) = w; } }
            }
        }
    }
}

__device__ __forceinline__ void phase_prep(const Params& p, int l, LAS unsigned char* lds) {
    unsigned char* ws = p.ws; LAS unsigned* tl = (LAS unsigned*)lds; int rot = 0;
    const float* win = p.in[I_WIN] + (size_t)l * DM * NIN;
    bf16_t* WIN = (bf16_t*)(ws + OFF_WIN);
    conv_job(win, NIN, DM, 0, 1536, WIN, DM, 0, tl, rot);
    conv_job(win, NIN, DM, 1552, 2048, WIN, DM, 1536, tl, rot);
    conv_job(win, NIN, DM, 3600, 2048, WIN, DM, 3584, tl, rot);
    conv_job(win, NIN, DM, 5656, 2048, WIN, DM, 5632, tl, rot);
    conv_job(win, NIN, DM, 1536, 16, WIN, DM, 7680, tl, rot);
    conv_job(win, NIN, DM, 5648, 8, WIN, DM, 7696, tl, rot);
    conv_job<1>(win, NIN, DM, 7704, 8192, (bf16_t*)(ws + OFF_WMG), DM, 0, tl, rot);
    for (int n = 0; n < 4; ++n) conv_job(p.in[I_WBR] + ((size_t)l * 4 + n) * 512 * DM, DM, 512, 0, DM, (bf16_t*)(ws + OFF_WBR) + (size_t)n * DM * 512, 512, 0, tl, rot);
    {
        u32x4* z = (u32x4*)(WIN + (size_t)7704 * DM); const int n16 = (NPROJ - 7704) * DM * 2 / 16;
        for (int i = blockIdx.x * 512 + threadIdx.x; i < n16; i += gridDim.x * 512) z[i] = (u32x4){0u, 0u, 0u, 0u};
    }
    if (l == 0) norm_rows2(p.in[I_XP], p.in[I_XS], p.in[I_NMG], (bf16_t*)(ws + OFF_H), nullptr, nullptr);
    else norm_rows2(p.out, p.out + O_YS, p.in[I_NMG] + DM, (bf16_t*)(ws + OFF_H), (const float*)(ws + OFF_BIG), p.out);
}

constexpr int LA_QT = 0, LA_KT = 17408, LA_KH = 34816, LA_VT = 53248, LA_ATT = 71680, LA_BB = 80896;
constexpr int LDQ = 136, LDT = 72, LDBB = 132;

struct LinRegs { u32x4 q0, q1, k0, k1, v0, v1, l0, l1; };
template <int MODE>
__device__ __forceinline__ void lin_load(const Params& p, int cgi, int h, int tid, LinRegs& R) {
    constexpr int K = (MODE == 0) ? 64 : 128, KPT = K / 8;
    constexpr int CQ = (MODE == 0) ? C_GLA_Q : (MODE == 1 ? C_HG_Q : C_RET_Q), CK = (MODE == 0) ? C_GLA_K : (MODE == 1 ? C_HG_F : C_RET_K),
                  CV = (MODE == 0) ? C_GLA_V : (MODE == 1 ? C_HG_I : C_RET_V);
    const int t = tid >> 3, sub = tid & 7, k0 = sub * KPT;
    const bf16_t* prow = (const bf16_t*)(p.ws + OFF_PROJ) + (size_t)(cgi * 64 + t) * NPROJ;
    const u32x4 z4 = {0u, 0u, 0u, 0u}; R.q0 = z4; R.q1 = z4; R.k0 = z4; R.k1 = z4; R.l0 = z4; R.l1 = z4;
    if (MODE == 0) { R.q0 = *(const u32x4*)(prow + CQ + h * 64 + k0); R.k0 = *(const u32x4*)(prow + CK + h * 64 + k0); R.l0 = *(const u32x4*)(prow + C_GLA_LR); R.l1 = *(const u32x4*)(prow + C_GLA_LR + 8); }
    if (MODE == 1) { R.q0 = *(const u32x4*)(prow + CQ + h * 128 + k0); R.q1 = *(const u32x4*)(prow + CQ + h * 128 + k0 + 8); R.k0 = *(const u32x4*)(prow + CK + h * 128 + k0); R.k1 = *(const u32x4*)(prow + CK + h * 128 + k0 + 8); }
    if (MODE == 2) { const int i0 = sub * 8; R.q0 = *(const u32x4*)(prow + CQ + h * 128 + i0); R.q1 = *(const u32x4*)(prow + CQ + h * 128 + 64 + i0); R.k0 = *(const u32x4*)(prow + CK + h * 128 + i0); R.k1 = *(const u32x4*)(prow + CK + h * 128 + 64 + i0); }
    R.v0 = *(const u32x4*)(prow + CV + h * 128 + sub * 16); R.v1 = *(const u32x4*)(prow + CV + h * 128 + sub * 16 + 8);
}
template <int MODE>
__device__ __forceinline__ void stepA_lin(const Params& p, int l, int cgi, int h, LAS unsigned char* lds, const LinRegs& R) {
    constexpr int K = (MODE == 0) ? 64 : 128, KPT = K / 8;
    int tid = threadIdx.x; asm volatile("" : "+v"(tid));
    const ChunkInfo ci = chunk_info(cgi); const int idx = cgi * 4 + h, t = tid >> 3, sub = tid & 7;
    bf16_t* proj = (bf16_t*)(p.ws + OFF_PROJ);
    LAS bf16_t* QT = (LAS bf16_t*)(lds + LA_QT); LAS bf16_t* KT = (LAS bf16_t*)(lds + LA_KT); LAS bf16_t* KH = (LAS bf16_t*)(lds + LA_KH);
    LAS bf16_t* VT = (LAS bf16_t*)(lds + LA_VT); LAS bf16_t* ATT = (LAS bf16_t*)(lds + LA_ATT); LAS float* BB = (LAS float*)(lds + LA_BB);
    bf16_t* prow = proj + (size_t)(ci.row0 + t) * NPROJ;
    constexpr int CQ = (MODE == 0) ? C_GLA_Q : (MODE == 1 ? C_HG_Q : C_RET_Q), CK = (MODE == 0) ? C_GLA_K : (MODE == 1 ? C_HG_F : C_RET_K),
                  CV = (MODE == 0) ? C_GLA_V : (MODE == 1 ? C_HG_I : C_RET_V);
    bf16_t* ST = (bf16_t*)(p.ws + (MODE == 0 ? OFF_ST_GLA : (MODE == 1 ? OFF_ST_HG : OFF_ST_RET))) + (size_t)idx * 128 * K;
    const int k0 = sub * KPT;
    const u32x4 rq0 = R.q0, rq1 = R.q1, rk0 = R.k0, rk1 = R.k1, rv0 = R.v0, rv1 = R.v1;
    float lbv[KPT];
    if (MODE == 1) {
#pragma unroll
        for (int j = 0; j < KPT; ++j) { if (l == 0) lbv[j] = 0.f; else { const float z0 = p.in[I_LB][h * 128 + k0 + j], z1 = p.in[I_LB][512 + h * 128 + k0 + j]; lbv[j] = sigm(z1 - z0); } }
    }
    if (MODE == 0) {
        const u32x4 l0 = R.l0, l1 = R.l1;
        float lr[16]; unpack8(l0, lr); unpack8(l1, lr + 8);
        const float* wgk = p.in[I_WGK] + (size_t)l * 16 * 256 + h * 64 + k0; const float* bgk = p.in[I_BGK] + l * 256 + h * 64 + k0;
        float gk[8];
#pragma unroll
        for (int j = 0; j < 8; ++j) gk[j] = bgk[j];
#pragma unroll
        for (int r = 0; r < 16; ++r) { const float4 w0 = *(const float4*)(wgk + r * 256), w1 = *(const float4*)(wgk + r * 256 + 4);
            gk[0] += lr[r] * w0.x; gk[1] += lr[r] * w0.y; gk[2] += lr[r] * w0.z; gk[3] += lr[r] * w0.w; gk[4] += lr[r] * w1.x; gk[5] += lr[r] * w1.y; gk[6] += lr[r] * w1.z; gk[7] += lr[r] * w1.w; }
#pragma unroll
        for (int j = 0; j < 8; ++j) BB[t * LDBB + k0 + j] = logsig(gk[j]) * (1.f / 16.f);
    } else if (MODE == 1) {
        float z[16]; unpack8(rk0, z); unpack8(rk1, z + 8);
#pragma unroll
        for (int j = 0; j < 16; ++j) { const float f = lbv[j] + (1.f - lbv[j]) * sigm(z[j]); BB[t * LDBB + k0 + j] = __logf(f); }
    }
    float lg2 = 0.f;
    if (MODE == 2) lg2 = __log2f(1.f - exp2f(-5.f - (float)h));
    if (MODE != 2) {
        lds_barrier();
        {
            LAS float* GT = (LAS float*)(lds + LA_ATT); const int kk_ = tid & (K - 1), g_ = tid / K; float pv[16];
            if (tid < 4 * K) { float run = 0.f;
#pragma unroll
                for (int i = 0; i < 16; ++i) { run += BB[(g_ * 16 + i) * LDBB + kk_]; pv[i] = run; }
                GT[g_ * K + kk_] = run; }
            lds_barrier();
            if (tid < 4 * K) { float off = 0.f;
#pragma unroll
                for (int g2 = 0; g2 < 3; ++g2) off += (g2 < g_) ? GT[g2 * K + kk_] : 0.f;
#pragma unroll
                for (int i = 0; i < 16; ++i) BB[(g_ * 16 + i) * LDBB + kk_] = pv[i] + off; }
        }
        lds_barrier();
    }
    {
        float q[KPT], kk[KPT];
        if (MODE == 0) {
            unpack8(rq0, q); unpack8(rk0, kk);
#pragma unroll
            for (int j = 0; j < 8; ++j) q[j] *= 0.125f;
        } else if (MODE == 1) {
            unpack8(rq0, q); unpack8(rq1, q + 8); unpack8(rk0, kk); unpack8(rk1, kk + 8);
#pragma unroll
            for (int j = 0; j < 16; ++j) { q[j] = silu(q[j]); const float f = lbv[j] + (1.f - lbv[j]) * sigm(kk[j]); kk[j] = 1.f - f; }
        }
        if (MODE != 2) {
            float qt[KPT], kt[KPT], qx[KPT];
#pragma unroll
            for (int j = 0; j < KPT; ++j) { const float b = BB[t * LDBB + k0 + j], bm = BB[31 * LDBB + k0 + j], be = BB[63 * LDBB + k0 + j];
                qt[j] = q[j] * expc(b - bm); kt[j] = kk[j] * expc(bm - b); qx[j] = q[j] * __expf(b);
                KH[swz64(k0 + j, t, LDT)] = f2bf(kk[j] * __expf(be - b));
                if (t == 63) ((float*)(p.ws + (MODE == 0 ? OFF_DEC_GLA : OFF_DEC_HG)))[(size_t)idx * K + k0 + j] = __expf(be); }
#pragma unroll
            for (int j = 0; j < KPT; j += 8) { *(LAS u32x4*)(QT + t * LDQ + k0 + j) = pack8(qt + j); *(LAS u32x4*)(KT + t * LDQ + k0 + j) = pack8(kt + j);
                *(u32x4*)(prow + CQ + h * K + k0 + j) = pack8(qx + j); }
        } else {
            const int i0 = sub * 8; const float pos = ci.pos0 + (float)t;
            float q1[8], q2[8], k1[8], k2[8];
            unpack8(rq0, q1); unpack8(rq1, q2); unpack8(rk0, k1); unpack8(rk1, k2);
            const float gq = exp2f(lg2 * (float)(t + 1)), gk_ = exp2f(lg2 * (float)(63 - t));
            float qa[8], qb[8], ka[8], kb[8], xa[8], xb[8];
#pragma unroll
            for (int j = 0; j < 8; ++j) {
                const float inv = exp2f(-(float)(i0 + j) * (13.287712379549449f / 64.f));
                const float ang = pos * inv;
                const float nrev = rintf(ang * 0.15915494309189535f);
                float rr = fmaf(-nrev, 6.2831854820251465f, ang); rr = fmaf(-nrev, -1.7484555e-7f, rr);
                const float cs = __cosf(rr), sn = __sinf(rr);
                qa[j] = q1[j] * cs - q2[j] * sn; qb[j] = q1[j] * sn + q2[j] * cs;
                const float ka_ = (k1[j] * cs - k2[j] * sn) * 0.08838834764831845f, kb_ = (k1[j] * sn + k2[j] * cs) * 0.08838834764831845f;
                ka[j] = ka_; kb[j] = kb_;
                KH[swz64(i0 + j, t, LDT)] = f2bf(ka_ * gk_); KH[swz64(64 + i0 + j, t, LDT)] = f2bf(kb_ * gk_);
                xa[j] = qa[j] * gq; xb[j] = qb[j] * gq;
            }
            *(LAS u32x4*)(QT + t * LDQ + i0) = pack8(qa); *(LAS u32x4*)(QT + t * LDQ + 64 + i0) = pack8(qb);
            *(LAS u32x4*)(KT + t * LDQ + i0) = pack8(ka); *(LAS u32x4*)(KT + t * LDQ + 64 + i0) = pack8(kb);
            *(u32x4*)(prow + CQ + h * 128 + i0) = pack8(xa); *(u32x4*)(prow + CQ + h * 128 + 64 + i0) = pack8(xb);
        }
        float v[16];
        unpack8(rv0, v); unpack8(rv1, v + 8);
#pragma unroll
        for (int j = 0; j < 16; ++j) VT[swz64(sub * 16 + j, t, LDT)] = f2bf(v[j]);
    }
    lds_barrier();
    lds_mm(QT, LDQ, KT, LDQ, 2, 2, K / 32, [&](int r, int c, f32x4 a) {
        float o[4];
#pragma unroll
        for (int j = 0; j < 4; ++j) { float x = a[j]; if (MODE == 2) x *= exp2f(lg2 * (float)(r - c - j)); o[j] = (c + j <= r) ? x : 0.f; }
        u32x2 w; w[0] = cvt_pk_bf16(o[0], o[1]); w[1] = cvt_pk_bf16(o[2], o[3]); *(LAS u32x2*)(ATT + r * LDT + c) = w; });
    {
        const float* sin_ = p.in[MODE == 0 ? I_SGLA : (MODE == 1 ? I_SHG : I_SRET)] + ((size_t)(l * 32 + ci.b) * 4 + h) * K * 128;
        float* sout = p.out + (MODE == 0 ? O_SGLA : (MODE == 1 ? O_SHG : O_SRET)) + ((size_t)(l * 32 + ci.b) * 4 + h) * K * 128;
        const float dret = exp2f(lg2 * 64.f);
        lds_mm<true, true>(VT, LDT, KH, LDT, 4, K / 32, 2, [&](int r, int c, f32x4 a) {
            u32x2 w;
            if (ci.sample) {
                float s0[4];
#pragma unroll
                for (int j = 0; j < 4; ++j) { s0[j] = sin_[(size_t)(c + j) * 128 + r]; const float d = (MODE == 2) ? dret : __expf(BB[63 * LDBB + c + j]); sout[(size_t)(c + j) * 128 + r] = d * s0[j] + a[j]; }
                w[0] = cvt_pk_bf16(s0[0], s0[1]); w[1] = cvt_pk_bf16(s0[2], s0[3]);
            } else { w[0] = cvt_pk_bf16(a[0], a[1]); w[1] = cvt_pk_bf16(a[2], a[3]); }
            *(u32x2*)(ST + (size_t)r * K + c) = w; });
    }
    lds_barrier();
    lds_mm<false, true>(ATT, LDT, VT, LDT, 2, 4, 2, [&](int r, int c, f32x4 a) {
        u32x2 w; w[0] = cvt_pk_bf16(a[0], a[1]); w[1] = cvt_pk_bf16(a[2], a[3]);
        *(u32x2*)(proj + (size_t)(ci.row0 + r) * NPROJ + CV + h * 128 + c) = w; });
    lds_barrier();
}

constexpr int LG_Q = 0, LG_K = 17408, LG_KT = 34816, LG_VT = 53248, LG_WT = 71680, LG_ATT = 90112, LG_MM = 99328, LG_SC = 116736;
constexpr int LDMM = 68;
__device__ __forceinline__ void stepA_gdn(const Params& p, int l, int cgi, int h, LAS unsigned char* lds) {
    int tid = threadIdx.x; asm volatile("" : "+v"(tid));
    const ChunkInfo ci = chunk_info(cgi); const int idx = cgi * 4 + h, t = tid >> 3, sub = tid & 7;
    const bf16_t* proj = (const bf16_t*)(p.ws + OFF_PROJ);
    LAS bf16_t* Q = (LAS bf16_t*)(lds + LG_Q); LAS bf16_t* KK = (LAS bf16_t*)(lds + LG_K); LAS bf16_t* KTr = (LAS bf16_t*)(lds + LG_KT);
    LAS bf16_t* VT = (LAS bf16_t*)(lds + LG_VT); LAS bf16_t* WT = (LAS bf16_t*)(lds + LG_WT); LAS bf16_t* ATT = (LAS bf16_t*)(lds + LG_ATT);
    LAS float* MM = (LAS float*)(lds + LG_MM); LAS float* SB = (LAS float*)(lds + LG_SC);
    const float* cw = p.in[I_GCW] + (size_t)l * 4 * 1536;
    const float* cache = p.in[I_CGDN] + (size_t)(l * 32 + ci.b) * 3 * 1536;
    float* cout = p.out + (ci.sample ? O_SGC + (size_t)(l * 32 + ci.b) * 3 * 1536 : O_PGC + (size_t)(l * 2 + ci.b) * 3 * 1536);
#pragma unroll
    for (int part = 0; part < 3; ++part) {
        const int ch0 = part * 512 + h * 128 + sub * 16;
        float acc[16];
#pragma unroll
        for (int c = 0; c < 16; ++c) acc[c] = 0.f;
#pragma unroll
        for (int j = 0; j < 4; ++j) {
            const int tr = t + j - 3; float x[16];
            if (tr >= 0 || !ci.first) { const bf16_t* sp = proj + (size_t)(ci.row0 + tr) * NPROJ + C_GDN_QKV + ch0; unpack8(*(const u32x4*)sp, x); unpack8(*(const u32x4*)(sp + 8), x + 8); }
            else if (ci.sample) { const float* sp = cache + (size_t)(t + j) * 1536 + ch0;
#pragma unroll
                for (int c = 0; c < 16; c += 4) { const float4 f = *(const float4*)(sp + c); x[c] = f.x; x[c + 1] = f.y; x[c + 2] = f.z; x[c + 3] = f.w; } }
            else {
#pragma unroll
                for (int c = 0; c < 16; ++c) x[c] = 0.f; }
            const float* wp = cw + j * 1536 + ch0;
#pragma unroll
            for (int c = 0; c < 16; c += 4) { const float4 w = *(const float4*)(wp + c); acc[c] += w.x * x[c]; acc[c + 1] += w.y * x[c + 1]; acc[c + 2] += w.z * x[c + 2]; acc[c + 3] += w.w * x[c + 3]; }
            if (j == 3 && ci.last && t >= 61) {
                float* op = cout + (size_t)(t - 61) * 1536 + ch0;
#pragma unroll
                for (int c = 0; c < 16; c += 4) *(float4*)(op + c) = make_float4(x[c], x[c + 1], x[c + 2], x[c + 3]); }
        }
        float ss = 0.f;
#pragma unroll
        for (int c = 0; c < 16; ++c) { acc[c] = silu(acc[c]); ss += acc[c] * acc[c]; }
        if (part < 2) {
            ss += __shfl_xor(ss, 1); ss += __shfl_xor(ss, 2); ss += __shfl_xor(ss, 4);
            const float rn = rsqrtf(ss + 1e-6f) * (part == 0 ? 0.08838834764831845f : 1.f);
#pragma unroll
            for (int c = 0; c < 16; ++c) acc[c] *= rn;
            LAS bf16_t* dst = (part == 0) ? Q : KK;
            *(LAS u32x4*)(dst + t * LDQ + sub * 16) = pack8(acc); *(LAS u32x4*)(dst + t * LDQ + sub * 16 + 8) = pack8(acc + 8);
            if (part == 1) {
#pragma unroll
                for (int c = 0; c < 16; ++c) KTr[(sub * 16 + c) * LDT + t] = f2bf(acc[c]); }
        } else {
#pragma unroll
            for (int c = 0; c < 16; ++c) VT[(sub * 16 + c) * LDT + t] = f2bf(acc[c]);
        }
    }
    if (tid < 64) {
        const bf16_t* pr = proj + (size_t)(ci.row0 + tid) * NPROJ;
        const float beta = sigm(bf2f(pr[C_GDN_B + h]));
        float g = -__expf(p.in[I_ALOG][l * 4 + h]) * softplus(bf2f(pr[C_GDN_A + h]) + p.in[I_DTB][l * 4 + h]);
#pragma unroll
        for (int o = 1; o < 64; o <<= 1) { const float n = __shfl_up(g, o); if (tid >= o) g += n; }
        SB[tid] = g; SB[64 + tid] = beta; SB[128 + tid] = beta * __expf(g);
    }
    lds_barrier();
    lds_mm(KK, LDQ, KK, LDQ, 2, 2, 4, [&](int r, int c, f32x4 a) {
        const float br = SB[r], be = SB[64 + r];
        f32x4 o;
#pragma unroll
        for (int j = 0; j < 4; ++j) o[j] = (c + j < r) ? be * a[j] * __expf(br - SB[c + j]) : 0.f;
        *(LAS f32x4*)(MM + r * LDMM + c) = o; });
    lds_mm(Q, LDQ, KK, LDQ, 2, 2, 4, [&](int r, int c, f32x4 a) {
        const float br = SB[r]; float o[4];
#pragma unroll
        for (int j = 0; j < 4; ++j) o[j] = (c + j <= r) ? a[j] * __expf(br - SB[c + j]) : 0.f;
        u32x2 w; w[0] = cvt_pk_bf16(o[0], o[1]); w[1] = cvt_pk_bf16(o[2], o[3]); *(LAS u32x2*)(ATT + r * LDT + c) = w; });
    lds_barrier();
    if (tid < 256) {
        const bool isk = tid < 128;
        LAS bf16_t* rowp = isk ? (KTr + tid * LDT) : (VT + (tid - 128) * LDT);
        LAS bf16_t* dstp = isk ? (WT + tid * LDT) : rowp;
        const LAS float* fac = isk ? (SB + 128) : (SB + 64);
#pragma unroll 1
        for (int b0 = 0; b0 < 64; b0 += 16) {
            float s[16];
            { float x[8]; unpack8(*(const LAS u32x4*)(rowp + b0), x);
#pragma unroll
              for (int j = 0; j < 8; ++j) s[j] = x[j] * fac[b0 + j];
              unpack8(*(const LAS u32x4*)(rowp + b0 + 8), x);
#pragma unroll
              for (int j = 0; j < 8; ++j) s[8 + j] = x[j] * fac[b0 + 8 + j]; }
#pragma unroll 1
            for (int jc = 0; jc < b0; jc += 8) {
                float w8[8]; unpack8(*(const LAS u32x4*)(dstp + jc), w8);
#pragma unroll
                for (int i = 0; i < 16; ++i) {
                    const f32x4 m0 = *(const LAS f32x4*)(MM + (b0 + i) * LDMM + jc), m1 = *(const LAS f32x4*)(MM + (b0 + i) * LDMM + jc + 4);
                    s[i] -= m0[0] * w8[0] + m0[1] * w8[1] + m0[2] * w8[2] + m0[3] * w8[3] + m1[0] * w8[4] + m1[1] * w8[5] + m1[2] * w8[6] + m1[3] * w8[7];
                }
            }
#pragma unroll
            for (int i = 1; i < 16; ++i) {
#pragma unroll
                for (int j = 0; j < i; ++j) s[i] -= MM[(b0 + i) * LDMM + b0 + j] * s[j];
            }
            *(LAS u32x4*)(dstp + b0) = pack8(s); *(LAS u32x4*)(dstp + b0 + 8) = pack8(s + 8);
        }
    }
    lds_barrier();
    {
        const int i = tid >> 2, s0 = (tid & 3) * 16; const float bend = SB[63];
        float x[16]; unpack8(*(const LAS u32x4*)(KTr + i * LDT + s0), x); unpack8(*(const LAS u32x4*)(KTr + i * LDT + s0 + 8), x + 8);
#pragma unroll
        for (int j = 0; j < 16; ++j) x[j] *= __expf(bend - SB[s0 + j]);
        *(LAS u32x4*)(KTr + i * LDT + s0) = pack8(x); *(LAS u32x4*)(KTr + i * LDT + s0 + 8) = pack8(x + 8);
    }
    bf16_t* GQX = (bf16_t*)(p.ws + OFF_GQX) + (size_t)idx * 64 * 128; bf16_t* GO0 = (bf16_t*)(p.ws + OFF_GO0) + (size_t)idx * 64 * 128;
    lds_mm(ATT, LDT, WT, LDT, 2, 4, 2, [&](int r, int c, f32x4 a) {
        const float eb = __expf(SB[r]); float o[4];
#pragma unroll
        for (int j = 0; j < 4; ++j) o[j] = bf2f(Q[r * LDQ + c + j]) * eb - a[j];
        u32x2 w; w[0] = cvt_pk_bf16(o[0], o[1]); w[1] = cvt_pk_bf16(o[2], o[3]); *(u32x2*)(GQX + r * 128 + c) = w; });
    lds_mm(ATT, LDT, VT, LDT, 2, 4, 2, [&](int r, int c, f32x4 a) {
        u32x2 w; w[0] = cvt_pk_bf16(a[0], a[1]); w[1] = cvt_pk_bf16(a[2], a[3]); *(u32x2*)(GO0 + r * 128 + c) = w; });
    lds_barrier();
    bf16_t* AG = (bf16_t*)(p.ws + OFF_A_GDN) + (size_t)idx * 128 * 128; bf16_t* BG = (bf16_t*)(p.ws + OFF_ST_GDN) + (size_t)idx * 128 * 128;
    const float ebe = __expf(SB[63]);
    lds_mm(KTr, LDT, WT, LDT, 4, 4, 2, [&](int r, int c, f32x4 a) {
        float o[4];
#pragma unroll
        for (int j = 0; j < 4; ++j) o[j] = ((r == c + j) ? ebe : 0.f) - a[j];
        u32x2 w; w[0] = cvt_pk_bf16(o[0], o[1]); w[1] = cvt_pk_bf16(o[2], o[3]); *(u32x2*)(AG + r * 128 + c) = w; });
    lds_mm(VT, LDT, KTr, LDT, 4, 4, 2, [&](int r, int c, f32x4 a) {
        u32x2 w; w[0] = cvt_pk_bf16(a[0], a[1]); w[1] = cvt_pk_bf16(a[2], a[3]); *(u32x2*)(BG + r * 128 + c) = w; });
    lds_barrier();
}

__device__ __forceinline__ void phase_stepA(const Params& p, int l, LAS unsigned char* lds) {
    const int G = gridDim.x; int it = blockIdx.x;
    for (; it < NITEM; it += G) stepA_gdn(p, l, it >> 2, it & 3, lds);
#define LIN_LOOP(MODE, BASE) { LinRegs R{}, N{}; const int tid_ = threadIdx.x; \
        if (it < (BASE) + NITEM) { const int j = it - (BASE); lin_load<MODE>(p, j >> 2, j & 3, tid_, R); } \
        for (; it < (BASE) + NITEM; it += G) { const int j = it - (BASE), jn = j + G; N = R; \
            if (it + G < (BASE) + NITEM) lin_load<MODE>(p, jn >> 2, jn & 3, tid_, N);        \
            stepA_lin<MODE>(p, l, j >> 2, j & 3, lds, R); R = N; } }
    LIN_LOOP(1, NITEM)
    LIN_LOOP(2, 2 * NITEM)
    LIN_LOOP(0, 3 * NITEM)
#undef LIN_LOOP
}

__device__ __forceinline__ void gdn_chain(const Params& p, int cg0, int nsteps, int h, int vs, const float* sin_, float* sout, LAS unsigned char* lds) {
    const int tid = threadIdx.x, wid = tid >> 6, lane = tid & 63, fr = lane & 15, fq = lane >> 4, i0 = wid * 16;
    constexpr int NS = 33, SLOT = 16 * LDQ;
    LAS bf16_t* XS = (LAS bf16_t*)lds;
    const bf16_t* AG = (const bf16_t*)(p.ws + OFF_A_GDN); bf16_t* SG = (bf16_t*)(p.ws + OFF_ST_GDN);
    constexpr int PD = 8, UNR = 32;
    bf16x8 af[PD][4]; u32x2 bt[PD];
#pragma unroll
    for (int u = 0; u < PD; ++u) {
        if (u < nsteps) { const size_t idx = (size_t)(cg0 + u) * 4 + h;
#pragma unroll
            for (int ks = 0; ks < 4; ++ks) af[u][ks] = *(const bf16x8*)(AG + (idx * 128 + i0 + fr) * 128 + ks * 32 + fq * 8);
            bt[u] = *(const u32x2*)(SG + (idx * 128 + vs * 16 + fr) * 128 + i0 + fq * 4); }
    }
    f32x4 cur = {0.f, 0.f, 0.f, 0.f};
    {
        const int k = tid >> 2, v4 = (tid & 3) * 4;
        float4 s = make_float4(0.f, 0.f, 0.f, 0.f);
        if (sin_) s = *(const float4*)(sin_ + (size_t)k * 128 + vs * 16 + v4);
        if (sin_) {
#pragma unroll
            for (int j = 0; j < 4; ++j) cur[j] = sin_[(size_t)(i0 + fq * 4 + j) * 128 + vs * 16 + fr]; }
        XS[(v4 + 0) * LDQ + k] = f2bf(s.x); XS[(v4 + 1) * LDQ + k] = f2bf(s.y); XS[(v4 + 2) * LDQ + k] = f2bf(s.z); XS[(v4 + 3) * LDQ + k] = f2bf(s.w);
    }
    lds_barrier();
    for (int c0 = 0; c0 < nsteps; c0 += UNR) {
        const int sb = c0 % NS;
#pragma unroll
        for (int uu = 0; uu < UNR; ++uu) {
            const int u = uu & (PD - 1), c = c0 + uu;
            if (c < nsteps) {
                int sr = sb + uu; sr = sr >= NS ? sr - NS : sr; int sw = sr + 1; sw = sw >= NS ? sw - NS : sw;
                f32x4 acc = {bflo(bt[u][0]), bfhi(bt[u][0]), bflo(bt[u][1]), bfhi(bt[u][1])};
                const LAS bf16_t* xs = XS + sr * SLOT + fr * LDQ + fq * 8;
                {
                    f32x4 acc2 = {0.f, 0.f, 0.f, 0.f};
                    const bf16x8 x0 = *(const LAS bf16x8*)(xs), x1 = *(const LAS bf16x8*)(xs + 32), x2 = *(const LAS bf16x8*)(xs + 64), x3 = *(const LAS bf16x8*)(xs + 96);
                    acc = __builtin_amdgcn_mfma_f32_16x16x32_bf16(af[u][0], x0, acc, 0, 0, 0); acc2 = __builtin_amdgcn_mfma_f32_16x16x32_bf16(af[u][1], x1, acc2, 0, 0, 0);
                    acc = __builtin_amdgcn_mfma_f32_16x16x32_bf16(af[u][2], x2, acc, 0, 0, 0); acc2 = __builtin_amdgcn_mfma_f32_16x16x32_bf16(af[u][3], x3, acc2, 0, 0, 0);
                    acc += acc2;
                }
                cur = acc;
                { u32x2 w; w[0] = cvt_pk_bf16(cur[0], cur[1]); w[1] = cvt_pk_bf16(cur[2], cur[3]); *(LAS u32x2*)(XS + sw * SLOT + fr * LDQ + i0 + fq * 4) = w; }
                if (c + PD < nsteps) { const size_t idn = (size_t)(cg0 + c + PD) * 4 + h;
#pragma unroll
                    for (int ks = 0; ks < 4; ++ks) af[u][ks] = *(const bf16x8*)(AG + (idn * 128 + i0 + fr) * 128 + ks * 32 + fq * 8);
                    bt[u] = *(const u32x2*)(SG + (idn * 128 + vs * 16 + fr) * 128 + i0 + fq * 4); }
                lds_barrier();
            }
        }
        const int nb = min(UNR, nsteps - c0), piece = tid & 255, prow = piece >> 4, pc8 = (piece & 15) * 8;
        for (int uu = tid >> 8; uu < nb; uu += 2) {
            int sr = sb + uu; sr = sr >= NS ? sr - NS : sr;
            const u32x4 v = *(const LAS u32x4*)(XS + sr * SLOT + prow * LDQ + pc8);
            *(u32x4*)(SG + (((size_t)(cg0 + c0 + uu) * 4 + h) * 128 + vs * 16 + prow) * 128 + pc8) = v;
        }
        lds_barrier();
    }
#pragma unroll
    for (int j = 0; j < 4; ++j) sout[(size_t)(i0 + fq * 4 + j) * 128 + vs * 16 + fr] = cur[j];
    lds_barrier();
}

template <int K, int HASD>
__device__ __forceinline__ void lin_chain(bf16_t* ST, const float* DEC, float dconst, int s, int h, int v, int kg, float* pout) {
    float S[8];
#pragma unroll
    for (int j = 0; j < 8; ++j) S[j] = 0.f;
    for (int c0 = 0; c0 < 128; c0 += 8) {
        u32x4 U[8]; float4 D0[8], D1[8];
#pragma unroll
        for (int u = 0; u < 8; ++u) { const size_t idx = (size_t)(s * 128 + c0 + u) * 4 + h;
            U[u] = *(const u32x4*)(ST + (idx * 128 + v) * K + kg * 8);
            if (HASD) { D0[u] = *(const float4*)(DEC + idx * K + kg * 8); D1[u] = *(const float4*)(DEC + idx * K + kg * 8 + 4); } }
#pragma unroll
        for (int u = 0; u < 8; ++u) { const size_t idx = (size_t)(s * 128 + c0 + u) * 4 + h;
            *(u32x4*)(ST + (idx * 128 + v) * K + kg * 8) = pack8(S);
            float uf[8]; unpack8(U[u], uf);
            if (HASD) { S[0] = D0[u].x * S[0] + uf[0]; S[1] = D0[u].y * S[1] + uf[1]; S[2] = D0[u].z * S[2] + uf[2]; S[3] = D0[u].w * S[3] + uf[3];
                        S[4] = D1[u].x * S[4] + uf[4]; S[5] = D1[u].y * S[5] + uf[5]; S[6] = D1[u].z * S[6] + uf[6]; S[7] = D1[u].w * S[7] + uf[7]; }
            else {
#pragma unroll
                for (int j = 0; j < 8; ++j) S[j] = dconst * S[j] + uf[j]; } }
    }
#pragma unroll
    for (int j = 0; j < 8; ++j) pout[(size_t)(kg * 8 + j) * 128 + v] = S[j];
}

__device__ __forceinline__ void late_weights(const Params& p, int l, LAS unsigned char* lds) {
    unsigned char* ws = p.ws; LAS unsigned* tl = (LAS unsigned*)lds; int rot = 0; const int first = 64, cnt = (int)gridDim.x - 64;
    lds_barrier();
    conv_job(p.in[I_WOUT] + (size_t)l * DM * DM, DM, DM, 0, DM, (bf16_t*)(ws + OFF_WOUT), DM, 0, tl, rot, first, cnt);
    conv_job<2>(p.in[I_WFI] + (size_t)l * DM * NFI, NFI, DM, 0, NFI, (bf16_t*)(ws + OFF_WFI), DM, 0, tl, rot, first, cnt);
    conv_job(p.in[I_WFO] + (size_t)l * DFF * DM, DM, DFF, 0, DM, (bf16_t*)(ws + OFF_WFO), DFF, 0, tl, rot, first, cnt);
}
__device__ __forceinline__ void phase_scan(const Params& p, int l, LAS unsigned char* lds) {
    const int bid = blockIdx.x, G = gridDim.x;
    if (bid < 64) {
        const int chain = bid >> 3, vs = bid & 7, s = chain >> 2, h = chain & 3;
        gdn_chain(p, s * 128, 128, h, vs, nullptr, p.out + O_PGDN + ((size_t)(l * 2 + s) * 4 + h) * 128 * 128, lds);
        return;
    }
    for (int j = bid - 64; j < 1024; j += G - 64) {
        const int b = j >> 5, h = (j >> 3) & 3, vs = j & 7;
        gdn_chain(p, 256 + b, 1, h, vs, p.in[I_SGDN] + ((size_t)(l * 32 + b) * 4 + h) * 128 * 128, p.out + O_SGDN + ((size_t)(l * 32 + b) * 4 + h) * 128 * 128, lds);
    }
    for (int e = (bid - 64) * 512 + (int)threadIdx.x; e < 40960; e += (G - 64) * 512) {
        const int sh = e / 5120, r = e - sh * 5120, s = sh >> 2, h = sh & 3;
        if (r < 1024) lin_chain<64, 1>((bf16_t*)(p.ws + OFF_ST_GLA), (const float*)(p.ws + OFF_DEC_GLA), 0.f, s, h, r >> 3, r & 7, p.out + O_PGLA + ((size_t)(l * 2 + s) * 4 + h) * 64 * 128);
        else if (r < 3072) { const int q = r - 1024; lin_chain<128, 1>((bf16_t*)(p.ws + OFF_ST_HG), (const float*)(p.ws + OFF_DEC_HG), 0.f, s, h, q >> 4, q & 15, p.out + O_PHG + ((size_t)(l * 2 + s) * 4 + h) * 128 * 128); }
        else { const int q = r - 3072; const float d = exp2f(64.f * __log2f(1.f - exp2f(-5.f - (float)h)));
            lin_chain<128, 0>((bf16_t*)(p.ws + OFF_ST_RET), nullptr, d, s, h, q >> 4, q & 15, p.out + O_PRET + ((size_t)(l * 2 + s) * 4 + h) * 128 * 128); }
    }
    late_weights(p, l, lds);
}

constexpr int LC_QX = 0, LC_SX = 17408, LC_O = 52224;
struct StepCItem { const bf16_t* qsrc; const bf16_t* osrc; const bf16_t* st; const bf16_t* gp; const float* ng; const float* nb; bf16_t* op; int ldq, ldo, K, br; };
struct StepCRegs { u32x4 s[4]; u32x4 q[2]; u32x2 o[4]; u32x4 g[2]; };
__device__ __forceinline__ StepCItem stepC_item(const Params& p, int l, int it, int t, int sub) {
    StepCItem I; const bf16_t* proj = (const bf16_t*)(p.ws + OFF_PROJ);
    const int br = it & 3, j = it >> 2, cgi = j >> 2, h = j & 3, idx = j, row0 = cgi * 64;
    int gcol; I.br = br; I.K = (br == 0) ? 64 : 128; I.nb = nullptr;
    if (br == 0) { I.qsrc = proj + (size_t)row0 * NPROJ + C_GLA_Q + h * 64; I.ldq = NPROJ; I.osrc = proj + (size_t)row0 * NPROJ + C_GLA_V + h * 128; I.ldo = NPROJ;
        I.st = (const bf16_t*)(p.ws + OFF_ST_GLA) + (size_t)idx * 128 * 64; gcol = C_GLA_G; I.ng = p.in[I_GLANG] + l * 128; }
    else if (br == 1) { I.qsrc = proj + (size_t)row0 * NPROJ + C_HG_Q + h * 128; I.ldq = NPROJ; I.osrc = proj + (size_t)row0 * NPROJ + C_HG_I + h * 128; I.ldo = NPROJ;
        I.st = (const bf16_t*)(p.ws + OFF_ST_HG) + (size_t)idx * 128 * 128; gcol = C_HG_G; I.ng = p.in[I_HGNG] + l * 128; }
    else if (br == 2) { I.qsrc = (const bf16_t*)(p.ws + OFF_GQX) + (size_t)idx * 64 * 128; I.ldq = 128; I.osrc = (const bf16_t*)(p.ws + OFF_GO0) + (size_t)idx * 64 * 128; I.ldo = 128;
        I.st = (const bf16_t*)(p.ws + OFF_ST_GDN) + (size_t)idx * 128 * 128; gcol = C_GDN_Z; I.ng = p.in[I_GDNNG] + l * 128; }
    else { I.qsrc = proj + (size_t)row0 * NPROJ + C_RET_Q + h * 128; I.ldq = NPROJ; I.osrc = proj + (size_t)row0 * NPROJ + C_RET_V + h * 128; I.ldo = NPROJ;
        I.st = (const bf16_t*)(p.ws + OFF_ST_RET) + (size_t)idx * 128 * 128; gcol = C_RET_G; I.ng = p.in[I_RETNG] + l * 128; I.nb = p.in[I_RETNB] + l * 128; }
    I.gp = proj + (size_t)(row0 + t) * NPROJ + gcol + h * 128 + sub * 16;
    I.op = (bf16_t*)(p.ws + OFF_OCAT) + (size_t)(row0 + t) * DM + br * 512 + h * 128 + sub * 16;
    return I;
}
__device__ __forceinline__ void stepC_load(const StepCItem& I, StepCRegs& R, int tid, int t, int sub, int r, int c0) {
    const int kpr = I.K / 8, npc = 128 * kpr;
#pragma unroll
    for (int i = 0; i < 4; ++i) { const int pc = tid + i * 512; if (pc < npc) { const int v = pc / kpr, kq = pc - v * kpr; R.s[i] = *(const u32x4*)(I.st + (size_t)v * I.K + kq * 8); } }
    if (sub * 16 < I.K) { const bf16_t* sp = I.qsrc + (size_t)t * I.ldq + sub * 16; R.q[0] = *(const u32x4*)sp; R.q[1] = *(const u32x4*)(sp + 8); }
    R.o[0] = *(const u32x2*)(I.osrc + (size_t)r * I.ldo + c0); R.o[1] = *(const u32x2*)(I.osrc + (size_t)r * I.ldo + c0 + 16);
    R.o[2] = *(const u32x2*)(I.osrc + (size_t)(r + 16) * I.ldo + c0); R.o[3] = *(const u32x2*)(I.osrc + (size_t)(r + 16) * I.ldo + c0 + 16);
    R.g[0] = *(const u32x4*)I.gp; R.g[1] = *(const u32x4*)(I.gp + 8);
}
__device__ __forceinline__ void phase_stepC(const Params& p, int l, LAS unsigned char* lds) {
    const int tid = threadIdx.x, t = tid >> 3, sub = tid & 7;
    LAS bf16_t* QX = (LAS bf16_t*)(lds + LC_QX); LAS bf16_t* SX = (LAS bf16_t*)(lds + LC_SX); LAS float* OB = (LAS float*)(lds + LC_O);
    const int wid = tid >> 6, lane = tid & 63, fr = lane & 15, fq = lane >> 4, r = (wid >> 2) * 32 + fr, c0 = (wid & 3) * 32 + fq * 4;
    int it = blockIdx.x;
    if (it >= 4 * NITEM) return;
    StepCItem I = stepC_item(p, l, it, t, sub); StepCRegs R;
    stepC_load(I, R, tid, t, sub, r, c0);
    for (; it < 4 * NITEM; it += gridDim.x) {
        { const int kpr = I.K / 8, npc = 128 * kpr;
#pragma unroll
          for (int i = 0; i < 4; ++i) { const int pc = tid + i * 512; if (pc < npc) { const int v = pc / kpr, kq = pc - v * kpr; *(LAS u32x4*)(SX + v * LDQ + kq * 8) = R.s[i]; } }
          if (sub * 16 < I.K) { *(LAS u32x4*)(QX + t * LDQ + sub * 16) = R.q[0]; *(LAS u32x4*)(QX + t * LDQ + sub * 16 + 8) = R.q[1]; } }
        const u32x2 o00 = R.o[0], o01 = R.o[1], o10 = R.o[2], o11 = R.o[3]; const u32x4 g0 = R.g[0], g1 = R.g[1];
        const StepCItem C = I;
        lds_barrier();
        const int itn = it + gridDim.x;
        if (itn < 4 * NITEM) { I = stepC_item(p, l, itn, t, sub); stepC_load(I, R, tid, t, sub, r, c0); }
        {
            f32x4 a00 = {0.f, 0.f, 0.f, 0.f}, a01 = a00, a10 = a00, a11 = a00;
            const LAS bf16_t* xp = QX + r * LDQ + fq * 8; const LAS bf16_t* yp = SX + ((wid & 3) * 32 + fr) * LDQ + fq * 8;
            for (int k = 0; k < C.K / 32; ++k) {
                const bf16x8 x0 = *(const LAS bf16x8*)(xp + k * 32), x1 = *(const LAS bf16x8*)(xp + 16 * LDQ + k * 32);
                const bf16x8 y0 = *(const LAS bf16x8*)(yp + k * 32), y1 = *(const LAS bf16x8*)(yp + 16 * LDQ + k * 32);
                a00 = __builtin_amdgcn_mfma_f32_16x16x32_bf16(y0, x0, a00, 0, 0, 0); a01 = __builtin_amdgcn_mfma_f32_16x16x32_bf16(y1, x0, a01, 0, 0, 0);
                a10 = __builtin_amdgcn_mfma_f32_16x16x32_bf16(y0, x1, a10, 0, 0, 0); a11 = __builtin_amdgcn_mfma_f32_16x16x32_bf16(y1, x1, a11, 0, 0, 0);
            }
            *(LAS f32x4*)(OB + r * LDBB + c0) = (f32x4){a00[0] + bflo(o00[0]), a00[1] + bfhi(o00[0]), a00[2] + bflo(o00[1]), a00[3] + bfhi(o00[1])};
            *(LAS f32x4*)(OB + r * LDBB + c0 + 16) = (f32x4){a01[0] + bflo(o01[0]), a01[1] + bfhi(o01[0]), a01[2] + bflo(o01[1]), a01[3] + bfhi(o01[1])};
            *(LAS f32x4*)(OB + (r + 16) * LDBB + c0) = (f32x4){a10[0] + bflo(o10[0]), a10[1] + bfhi(o10[0]), a10[2] + bflo(o10[1]), a10[3] + bfhi(o10[1])};
            *(LAS f32x4*)(OB + (r + 16) * LDBB + c0 + 16) = (f32x4){a11[0] + bflo(o11[0]), a11[1] + bfhi(o11[0]), a11[2] + bflo(o11[1]), a11[3] + bfhi(o11[1])};
        }
        lds_barrier();
        {
            float o[16]; float s1 = 0.f, s2 = 0.f;
#pragma unroll
            for (int c = 0; c < 16; c += 4) { const f32x4 v = *(const LAS f32x4*)(OB + t * LDBB + sub * 16 + c); o[c] = v[0]; o[c + 1] = v[1]; o[c + 2] = v[2]; o[c + 3] = v[3]; }
#pragma unroll
            for (int c = 0; c < 16; ++c) { s1 += o[c]; s2 += o[c] * o[c]; }
            s1 += __shfl_xor(s1, 1); s1 += __shfl_xor(s1, 2); s1 += __shfl_xor(s1, 4);
            s2 += __shfl_xor(s2, 1); s2 += __shfl_xor(s2, 2); s2 += __shfl_xor(s2, 4);
            float mu = 0.f, rs;
            if (C.br == 3) { mu = s1 * (1.f / 128.f); const float var = fmaxf(s2 * (1.f / 128.f) - mu * mu, 0.f); rs = rsqrtf(var + 1e-6f); }
            else rs = rsqrtf(s2 * (1.f / 128.f) + 1e-6f);
            float gt[16]; unpack8(g0, gt); unpack8(g1, gt + 8);
            float y[16];
#pragma unroll
            for (int c = 0; c < 16; ++c) { float v = (o[c] - mu) * rs * C.ng[sub * 16 + c]; if (C.br == 3) v += C.nb[sub * 16 + c]; y[c] = v * silu(gt[c]); }
            *(u32x4*)C.op = pack8(y); *(u32x4*)(C.op + 8) = pack8(y + 8);
        }
        lds_barrier();
    }
}

__device__ __forceinline__ void phase_ffn_fix(const Params& p, int l) {
    const bf16_t* halo = (const bf16_t*)(p.ws + OFF_HALO); bf16_t* act = (bf16_t*)(p.ws + OFF_ACT);
    const float* cw = p.in[I_FCW] + (size_t)l * 3 * DFF; const float* cb = p.in[I_FCB] + (size_t)l * DFF;
    const bool split = (gridDim.x == 256);
    for (int w = blockIdx.x * 512 + threadIdx.x; w < NCHUNK * 688; w += gridDim.x * 512) {
        const int cgi = w / 688, j0 = (w - cgi * 688) * 8;
        if (split && cgi >= pg8::FFN_SPLIT_PM0 * 4 && j0 >= pg8::FFN_SPLIT_PN * 128) continue;
        const ChunkInfo ci = chunk_info(cgi);
        float a0[8], a1[8], u0[8], u1[8], h1[8], h2[8], y0[8], y1[8];
        const bf16_t* hc = halo + (size_t)cgi * 8 * DFF + j0;
        unpack8(*(const u32x4*)hc, a0); unpack8(*(const u32x4*)(hc + DFF), u0); unpack8(*(const u32x4*)(hc + 2 * DFF), a1); unpack8(*(const u32x4*)(hc + 3 * DFF), u1);
        if (!ci.first) { const bf16_t* hp = halo + (size_t)(cgi - 1) * 8 * DFF + j0; unpack8(*(const u32x4*)(hp + 4 * DFF), h2); unpack8(*(const u32x4*)(hp + 6 * DFF), h1); }
        else if (ci.sample) { const float* cp = p.in[I_CFFN] + (size_t)(l * 32 + ci.b) * 2 * DFF + j0;
#pragma unroll
            for (int c = 0; c < 8; ++c) { h2[c] = cp[c]; h1[c] = cp[DFF + c]; } }
        else {
#pragma unroll
            for (int c = 0; c < 8; ++c) { h1[c] = 0.f; h2[c] = 0.f; } }
#pragma unroll
        for (int c = 0; c < 8; ++c) { const float k0 = cw[j0 + c], k1 = cw[DFF + j0 + c], k2 = cw[2 * DFF + j0 + c], b = cb[j0 + c];
            y0[c] = silu(k0 * h2[c] + k1 * h1[c] + k2 * a0[c] + b) * u0[c]; y1[c] = silu(k0 * h1[c] + k1 * a0[c] + k2 * a1[c] + b) * u1[c]; }
        *(u32x4*)(act + (size_t)ci.row0 * DFF + j0) = pack8(y0); *(u32x4*)(act + (size_t)(ci.row0 + 1) * DFF + j0) = pack8(y1);
        if (ci.last) { float* co = p.out + (ci.sample ? O_SFC + (size_t)(l * 32 + ci.b) * 2 * DFF : O_PFC + (size_t)(l * 2 + ci.b) * 2 * DFF) + j0;
            float e0[8], e1[8]; unpack8(*(const u32x4*)(hc + 4 * DFF), e0); unpack8(*(const u32x4*)(hc + 6 * DFF), e1);
            *(float4*)co = make_float4(e0[0], e0[1], e0[2], e0[3]); *(float4*)(co + 4) = make_float4(e0[4], e0[5], e0[6], e0[7]);
            *(float4*)(co + DFF) = make_float4(e1[0], e1[1], e1[2], e1[3]); *(float4*)(co + DFF + 4) = make_float4(e1[4], e1[5], e1[6], e1[7]); }
    }
    if (split) {
        const float* pf = (const float*)(p.ws + OFF_PARTF);
        constexpr int CH0 = pg8::FFN_SPLIT_PM0 * 4, JC0 = pg8::FFN_SPLIT_PN * 128;
        for (int w = blockIdx.x * 512 + threadIdx.x; w < (NCHUNK - CH0) * 4 * 128; w += gridDim.x * 512) {
            const int c = w & 127, qq = (w >> 7) & 3, cgi = CH0 + (w >> 9), j = JC0 + c;
            const ChunkInfo ci = chunk_info(cgi);
            const float k0 = cw[j], k1 = cw[DFF + j], k2 = cw[2 * DFF + j], bb = cb[j];
            auto gate_at = [&](int row) -> float {
                const float* q = pf + ((size_t)((row >> 8) - pg8::FFN_SPLIT_PM0) * 65536) + (size_t)(row & 255) * 256 + c;
                return q[0] + q[(size_t)24 * 65536] + q[(size_t)48 * 65536] + q[(size_t)72 * 65536]; };
            auto up_at = [&](int row) -> float {
                const float* q = pf + ((size_t)((row >> 8) - pg8::FFN_SPLIT_PM0) * 65536) + (size_t)(row & 255) * 256 + 128 + c;
                return q[0] + q[(size_t)24 * 65536] + q[(size_t)48 * 65536] + q[(size_t)72 * 65536]; };
            const int t0 = qq * 16, r0 = ci.row0 + t0;
            float h1, h2;
            if (t0 > 0 || (!ci.first && cgi > CH0)) { h1 = gate_at(r0 - 1); h2 = gate_at(r0 - 2); }
            else if (!ci.first) { const bf16_t* hp = halo + (size_t)(cgi - 1) * 8 * DFF + j; h2 = bf2f(hp[4 * DFF]); h1 = bf2f(hp[6 * DFF]); }
            else if (ci.sample) { const float* cp = p.in[I_CFFN] + (size_t)(l * 32 + ci.b) * 2 * DFF + j; h2 = cp[0]; h1 = cp[DFF]; }
            else { h1 = 0.f; h2 = 0.f; }
            float* co = p.out + (ci.sample ? O_SFC + (size_t)(l * 32 + ci.b) * 2 * DFF : O_PFC + (size_t)(l * 2 + ci.b) * 2 * DFF) + j;
#pragma unroll 4
            for (int t = 0; t < 16; ++t) {
                const int row = r0 + t; const float a = gate_at(row), uu = up_at(row);
                act[(size_t)row * DFF + j] = f2bf(silu(k0 * h2 + k1 * h1 + k2 * a + bb) * uu);
                if (ci.last && t0 + t >= 62) co[(size_t)(t0 + t - 62) * DFF] = a;
                h2 = h1; h1 = a;
            }
        }
    }
}

#define XB_TMO      128
#define XB_XCNT(j)  (256  + 64 * (j))
#define XB_XSUB(j)  (1280 + 64 * (j))
#define XB_XGEN(j)  (2304 + 64 * (j))
#define XB_TOP      3328
#define XB_TOPGEN   3392
#define XCD_BAR_WORDS 3456
#define XB_SPIN_CAP (1u << 23)
__device__ __forceinline__ unsigned xb_ld(unsigned* p)              { return __hip_atomic_load(p, __ATOMIC_RELAXED, __HIP_MEMORY_SCOPE_AGENT); }
__device__ __forceinline__ unsigned xb_add(unsigned* p, unsigned v) { return __hip_atomic_fetch_add(p, v, __ATOMIC_RELAXED, __HIP_MEMORY_SCOPE_AGENT); }
__device__ __forceinline__ unsigned xb_xcc_id() { return (unsigned)__builtin_amdgcn_s_getreg((3 << 11) | 20) & 0xFu; }
#define XB_SPIN(cond, bar) do { unsigned _sp = 0; while (cond) { __builtin_amdgcn_s_sleep(1); \
    if ((++_sp & 255u) == 0u) { if (xb_ld(&(bar)[XB_TMO])) break; if (_sp > XB_SPIN_CAP) { atomicAdd(&(bar)[XB_TMO], 1u); break; } } } } while (0)
struct XcdBarrier { unsigned* bar; unsigned x; volatile LAS unsigned* st; };
__device__ __forceinline__ XcdBarrier xcd_barrier_post(unsigned* bar, volatile LAS unsigned* st) {
    XcdBarrier b; b.bar = bar; b.x = xb_xcc_id(); b.st = st;
    if (threadIdx.x == 0) (void)xb_add(&bar[XB_XCNT(b.x)], 1u);
    return b;
}
__device__ __forceinline__ void xcd_barrier_complete(unsigned* bar, unsigned x, unsigned& nloc, unsigned& nx) {
    const unsigned G = gridDim.x * gridDim.y * gridDim.z;
    unsigned sum, cnt, mine, sp = 0u;
    for (;;) {
        sum = 0u; cnt = 0u; mine = 0u;
#pragma unroll
        for (unsigned j = 0; j < 16; ++j) { const unsigned c = xb_ld(&bar[XB_XCNT(j)]); sum += c; cnt += (c > 0u) ? 1u : 0u; mine = (j == x) ? c : mine; }
        if (sum == G) break;
        __builtin_amdgcn_s_sleep(1);
        if ((++sp & 255u) == 0u) { if (xb_ld(&bar[XB_TMO])) break; if (sp > XB_SPIN_CAP) { atomicAdd(&bar[XB_TMO], 1u); break; } }
    }
    nloc = mine > 0u ? mine : 1u; nx = cnt > 0u ? cnt : 1u;
}
__device__ __forceinline__ void xcd_barrier(const XcdBarrier& b) {
    asm volatile("s_waitcnt vmcnt(0)" ::: "memory");
    __syncthreads();
    if (threadIdx.x == 0) {
        unsigned* bar = b.bar;
        __builtin_amdgcn_s_waitcnt(0);
        unsigned nloc = b.st[0], nx = b.st[1];
        if (nloc == 0u) { xcd_barrier_complete(bar, b.x, nloc, nx); b.st[0] = nloc; b.st[1] = nx; }
        const unsigned old = xb_add(&bar[XB_XSUB(b.x)], 1u);
        const unsigned gen = old / nloc;
        if (old + 1u == (gen + 1u) * nloc) {
            __builtin_amdgcn_fence(__ATOMIC_RELEASE, "agent");
            asm volatile("s_waitcnt vmcnt(0)" ::: "memory");
            const unsigned og = xb_add(&bar[XB_TOP], 1u);
            const unsigned tg = og / nx;
            if (og + 1u == (tg + 1u) * nx) xb_add(&bar[XB_TOPGEN], 1u);
            else XB_SPIN(xb_ld(&bar[XB_TOPGEN]) == tg, bar);
            __builtin_amdgcn_fence(__ATOMIC_ACQUIRE, "agent");
            xb_add(&bar[XB_XGEN(b.x)], 1u);
            asm volatile("s_waitcnt vmcnt(0)" ::: "memory");
        } else {
            XB_SPIN(xb_ld(&bar[XB_XGEN(b.x)]) == gen, bar);
            __builtin_amdgcn_fence(__ATOMIC_ACQUIRE, "agent");
            asm volatile("s_waitcnt vmcnt(0)" ::: "memory");
        }
    }
    __syncthreads();
}

constexpr int PH_PER_LAYER = 12, N_PHASES = 2 * PH_PER_LAYER + 1;


template <int PH>
__device__ __forceinline__ void run_phase(const Params& p, LAS unsigned char* lds) {
    unsigned char* ws = p.ws; const int G = gridDim.x, c = blockIdx.x;
    constexpr int l = PH / PH_PER_LAYER, q = PH - l * PH_PER_LAYER;
    if constexpr (PH == 2 * PH_PER_LAYER) { norm_rows2<true>(p.out, p.out + O_YS, p.in[I_NFIN], nullptr, (const float*)(ws + OFF_BIG), nullptr, p.out); }
    else if constexpr (q == 0) phase_prep(p, l, lds);
    else if constexpr (q == 1) { pg8::TileOrder S{(const char*)(ws + OFF_H), (const char*)(ws + OFF_WIN), DM, DM, M_TOK / 256, NPROJ / 256, G, c, DM / 64};
              pg8::EpiBf16<0> E{(bf16_t*)(ws + OFF_PROJ), NPROJ}; pg8::gemm_phase(lds, DM, DM, DM, S, E); }
    else if constexpr (q == 2) phase_stepA(p, l, lds);
    else if constexpr (q == 3) phase_scan(p, l, lds);
    else if constexpr (q == 4) phase_stepC(p, l, lds);
    else if constexpr (q == 5) { pg8::BranchOrder S{(const char*)(ws + OFF_OCAT), (const char*)(ws + OFF_WBR), M_TOK / 256, NMG / 256, G, c};
              pg8::EpiBf16<0> E{(bf16_t*)(ws + OFF_PB), NMG}; pg8::gemm_phase(lds, DM, 512, 512, S, E); }
    else if constexpr (q == 6) { pg8::TileOrder S{(const char*)(ws + OFF_H), (const char*)(ws + OFF_WMG), DM, DM, M_TOK / 256, NMG / 256, G, c, DM / 64};
              pg8::EpiMerge E{(const bf16_t*)(ws + OFF_PB), (bf16_t*)(ws + OFF_OCAT)}; pg8::gemm_phase(lds, DM, DM, DM, S, E); }
    else if constexpr (q == 7) { pg8::SplitOrder S{(const char*)(ws + OFF_OCAT), (const char*)(ws + OFF_WOUT), DM, DM, G, c, DM / 64};
              pg8::EpiResid E{l == 0 ? p.in[I_XP] : p.out, l == 0 ? p.in[I_XS] : p.out + O_YS, p.out, (float*)(ws + OFF_BIG)}; pg8::gemm_phase(lds, DM, DM, DM, S, E); }
    else if constexpr (q == 8) norm_rows2(p.out, l == 0 ? p.in[I_XS] : p.out + O_YS, p.in[I_NFG] + l * DM, (bf16_t*)(ws + OFF_H), (const float*)(ws + OFF_BIG), p.out);
    else if constexpr (q == 9) { pg8::FfnOrder S{(const char*)(ws + OFF_H), (const char*)(ws + OFF_WFI), G, c};
              pg8::EpiFfn E{(bf16_t*)(ws + OFF_ACT), (bf16_t*)(ws + OFF_HALO), p.in[I_FCW] + (size_t)l * 3 * DFF, p.in[I_FCB] + (size_t)l * DFF, (float*)(ws + OFF_PARTF)}; pg8::gemm_phase(lds, DM, DM, DM, S, E); }
    else if constexpr (q == 10) phase_ffn_fix(p, l);
    else { pg8::SplitOrder S{(const char*)(ws + OFF_ACT), (const char*)(ws + OFF_WFO), DFF, DFF, G, c, DFF / 64};
               pg8::EpiResid E{p.out, p.out + O_YS, p.out, (float*)(ws + OFF_BIG)}; pg8::gemm_phase(lds, DFF, DFF, DFF, S, E); }
}

__global__ void __launch_bounds__(512, 2) fwd_kernel(Params p, int ph_lo, int ph_hi) {
    extern __shared__ __attribute__((aligned(16))) unsigned char shm[];
    LAS unsigned char* lds = (LAS unsigned char*)shm;
    volatile LAS unsigned* stw = (volatile LAS unsigned*)(lds + LDS_BYTES - 16);
    if (threadIdx.x == 0) { stw[0] = 0u; stw[1] = 0u; }
    __syncthreads();
    XcdBarrier xb{(unsigned*)(p.ws + OFF_BAR), 0u, stw};
    if (ph_hi - ph_lo > 1) xb = xcd_barrier_post((unsigned*)(p.ws + OFF_BAR), stw);
    if (ph_lo < 0) { __threadfence(); cg::this_grid().sync(); }
#define RUN(PH) if (ph_lo <= PH && PH < ph_hi) { run_phase<PH>(p, lds); if (PH + 1 < ph_hi) xcd_barrier(xb); }
    RUN(0) RUN(1) RUN(2) RUN(3) RUN(4) RUN(5) RUN(6) RUN(7) RUN(8) RUN(9) RUN(10) RUN(11)
    RUN(12) RUN(13) RUN(14) RUN(15) RUN(16) RUN(17) RUN(18) RUN(19) RUN(20) RUN(21) RUN(22) RUN(23) RUN(24)
#undef RUN
}

extern "C" void kernel_launch(void* const* d_in, const int* in_sizes, int n_in, void* d_out, int out_size, void* d_ws, size_t ws_size, hipStream_t stream) {
    static int grid = 0;
    if (grid == 0) {
        if (n_in != 29 || (size_t)out_size != O_END || ws_size < WS_TOTAL) { fprintf(stderr, "kernel_launch: unexpected shapes n_in %d out %d ws %zu (need %zu)\n", n_in, out_size, ws_size, (size_t)WS_END); grid = -1; return; }
        int dev = 0, cus = 0, per_cu = 0;
        (void)hipGetDevice(&dev); (void)hipDeviceGetAttribute(&cus, hipDeviceAttributeMultiprocessorCount, dev);
        if (hipFuncSetAttribute((const void*)fwd_kernel, hipFuncAttributeMaxDynamicSharedMemorySize, LDS_BYTES) != hipSuccess) { fprintf(stderr, "kernel_launch: hipFuncSetAttribute failed\n"); grid = -1; return; }
        if (hipOccupancyMaxActiveBlocksPerMultiprocessor(&per_cu, (const void*)fwd_kernel, 512, LDS_BYTES) != hipSuccess || per_cu < 1) { fprintf(stderr, "kernel_launch: occupancy query says %d\n", per_cu); per_cu = 1; }
        (void)hipGetLastError();
        grid = cus;
        if (grid < 128) grid = -1;
    }
    if (grid < 0) return;
    Params p{};
    for (int i = 0; i < 29; ++i) p.in[i] = (const float*)d_in[i];
    p.out = (float*)d_out; p.ws = (unsigned char*)d_ws;
#if MK_MULTI
    for (int ph = 0; ph < N_PHASES; ++ph) hipLaunchKernelGGL(fwd_kernel, dim3(grid), dim3(512), LDS_BYTES, stream, p, ph, ph + 1);
#else
    (void)hipMemsetAsync((unsigned char*)d_ws + OFF_BAR, 0, XCD_BAR_WORDS * 4, stream);
    int lo = 0, hi = N_PHASES;
    void* args[] = {&p, &lo, &hi};
    hipError_t e = hipLaunchCooperativeKernel((const void*)fwd_kernel, dim3(grid), dim3(512), args, LDS_BYTES, stream);
    if (e != hipSuccess) fprintf(stderr, "cooperative launch failed: %s (grid %d)\n", hipGetErrorString(e), grid);
#endif
}
```
